# Optimizing an MI355X kernel written in HIP

```python
import math
import jax, jax.numpy as jnp
from jax import lax
import numpy as np

D_MODEL = 1024
BATCH = 16
SEQ = 4096
DEPTH = 2
DEC_BATCH = 8
DEC_SEQ = 8192
PAST_LEN = 128

BLOCK = 128
EPS = 1e-6
A_HEADS = 4
A_HEAD_DIM = 64
A_VDIM = 2 * A_HEAD_DIM
A_QK = A_HEADS * 2 * A_HEAD_DIM
A_WIDTH = A_HEADS * A_VDIM
B_HEADS = 8
B_KV_HEADS = 2
B_GROUP = B_HEADS // B_KV_HEADS
B_HEAD_DIM = 64
B_WIDTH = B_HEADS * B_HEAD_DIM
B_KV = B_KV_HEADS * B_HEAD_DIM
WINDOW = 128
D_FF = 2816
CONV_WIDTH = 3
SPLIT_SIZES = (A_QK, A_QK, A_WIDTH, B_WIDTH, B_KV, B_KV, D_MODEL, D_MODEL)
SPLIT_IDX = tuple(int(i) for i in np.cumsum(SPLIT_SIZES)[:-1])
IN_COLS = int(sum(SPLIT_SIZES))
NEG = -1e30

kernel_name = "hybrid_diffattn_swa_sink_convffn_encoder"


def rmsnorm(x, g):
    xf = x.astype(jnp.float32)
    y = xf * lax.rsqrt(jnp.mean(xf * xf, axis=-1, keepdims=True) + EPS)
    return (y * g.astype(jnp.float32)).astype(x.dtype)


def alibi_slopes(n):
    return jnp.asarray([2.0 ** (-8.0 * (h + 1) / n) for h in range(n)], dtype=jnp.float32)


def diff_attention(q, k, v, lam, lam_init, sub_g):
    B, S = q.shape[0], q.shape[1]
    nb = S // BLOCK
    scale = A_HEAD_DIM ** -0.5
    slopes = alibi_slopes(A_HEADS)[:, None, None, None]
    kpos = jnp.arange(S, dtype=jnp.float32)
    qb = q.reshape(B, nb, BLOCK, A_HEADS, 2, A_HEAD_DIM).transpose(1, 0, 2, 3, 4, 5)

    def one_block(args):
        qi, i = args
        s = jnp.einsum('bqhcd,bkhcd->bhcqk', qi, k).astype(jnp.float32) * scale
        qpos = (i * BLOCK + jnp.arange(BLOCK)).astype(jnp.float32)
        dist = jnp.abs(qpos[:, None] - kpos[None, :])
        p = jax.nn.softmax(s - slopes * dist, axis=-1)
        a = p[:, :, 0] - lam * p[:, :, 1]
        return jnp.einsum('bhqk,bkhe->bqhe', a.astype(v.dtype), v)

    o = lax.map(one_block, (qb, jnp.arange(nb)))
    o = o.transpose(1, 0, 2, 3, 4).reshape(B, S, A_HEADS, A_VDIM)
    o = rmsnorm(o, sub_g) * (1.0 - lam_init)
    return o.reshape(B, S, A_WIDTH)


def window_attention(q, k, v, sink):
    B, S = q.shape[0], q.shape[1]
    nb = S // BLOCK
    scale = B_HEAD_DIM ** -0.5
    kp = jnp.pad(k, ((0, 0), (BLOCK, BLOCK), (0, 0), (0, 0)))
    vp = jnp.pad(v, ((0, 0), (BLOCK, BLOCK), (0, 0), (0, 0)))
    qb = q.reshape(B, nb, BLOCK, B_KV_HEADS, B_GROUP, B_HEAD_DIM).transpose(1, 0, 2, 3, 4, 5)
    slopes = alibi_slopes(B_HEADS).reshape(B_KV_HEADS, B_GROUP)[:, :, None, None]
    sink_g = sink.astype(jnp.float32).reshape(B_KV_HEADS, B_GROUP)[:, :, None, None]
    qi_idx = jnp.arange(BLOCK)
    kj_idx = jnp.arange(3 * BLOCK)
    rel = kj_idx[None, :] - qi_idx[:, None]
    band = (rel >= BLOCK - WINDOW) & (rel <= BLOCK + WINDOW)
    dist = jnp.abs(rel - BLOCK).astype(jnp.float32)

    def one_block(args):
        qi, i = args
        kw = lax.dynamic_slice_in_dim(kp, i * BLOCK, 3 * BLOCK, axis=1)
        vw = lax.dynamic_slice_in_dim(vp, i * BLOCK, 3 * BLOCK, axis=1)
        kpos = (i - 1) * BLOCK + kj_idx
        valid = band & ((kpos >= 0) & (kpos < S))[None, :]
        s = jnp.einsum('bqgrd,bkgd->bgrqk', qi, kw).astype(jnp.float32) * scale - slopes * dist
        s = jnp.where(valid, s, NEG)
        m = jnp.maximum(jnp.max(s, axis=-1, keepdims=True), sink_g)
        e = jnp.exp(s - m)
        p = e / (jnp.sum(e, axis=-1, keepdims=True) + jnp.exp(sink_g - m))
        return jnp.einsum('bgrqk,bkgd->bqgrd', p.astype(v.dtype), vw)

    o = lax.map(one_block, (qb, jnp.arange(nb)))
    return o.transpose(1, 0, 2, 3, 4, 5).reshape(B, S, B_WIDTH)


def dwconv_centred(a, w, b):
    ap = jnp.pad(a, ((0, 0), (1, 1), (0, 0)))
    return ap[:, :-2] * w[0] + ap[:, 1:-1] * w[1] + ap[:, 2:] * w[2] + b


def trunk_layer(x, l, attn_norm, w_in, gate_bias, lambda_q1, lambda_k1, lambda_q2, lambda_k2,
                subln, sink, w_proj_a, w_proj_b, w_out, ffn_norm, w_up, conv_w, conv_b, w_down):
    B, S = x.shape[0], x.shape[1]
    lam_init = 0.8 - 0.6 * math.exp(-0.3 * l)
    h = rmsnorm(x, attn_norm[l])
    proj = h @ w_in[l]
    qa, ka, va, qb, kb, vb, ga, gb = jnp.split(proj, SPLIT_IDX, axis=-1)
    lam = (jnp.exp(jnp.sum(lambda_q1[l].astype(jnp.float32) * lambda_k1[l].astype(jnp.float32)))
           - jnp.exp(jnp.sum(lambda_q2[l].astype(jnp.float32) * lambda_k2[l].astype(jnp.float32)))
           + lam_init)
    ya = diff_attention(qa.reshape(B, S, A_HEADS, 2, A_HEAD_DIM),
                        ka.reshape(B, S, A_HEADS, 2, A_HEAD_DIM),
                        va.reshape(B, S, A_HEADS, A_VDIM), lam, lam_init, subln[l])
    yb = window_attention(qb.reshape(B, S, B_KV_HEADS, B_GROUP, B_HEAD_DIM),
                          kb.reshape(B, S, B_KV_HEADS, B_HEAD_DIM),
                          vb.reshape(B, S, B_KV_HEADS, B_HEAD_DIM), sink[l])
    bga, bgb = jnp.split(gate_bias[l], 2)
    merged = (jax.nn.sigmoid(ga + bga) * (ya @ w_proj_a[l])
              + jax.nn.sigmoid(gb + bgb) * (yb @ w_proj_b[l]))
    x = x + merged @ w_out[l]
    h = rmsnorm(x, ffn_norm[l])
    a, v = jnp.split(h @ w_up[l], 2, axis=-1)
    a = dwconv_centred(a, conv_w[l], conv_b[l])
    return x + (jax.nn.gelu(a) * v) @ w_down[l]


def setup_inputs(seed: int = 0) -> dict:
    key = jax.random.key(seed)
    ks = jax.random.split(key, 20)
    f32 = jnp.float32
    nrm = lambda k, shp, s: jax.random.normal(k, shp, f32) * s
    return {
        "x_prompt": nrm(ks[0], (BATCH, SEQ, D_MODEL), 1.0),
        "x_sample": nrm(ks[1], (DEC_BATCH, DEC_SEQ, D_MODEL), 1.0),
        "attn_norm": 1.0 + nrm(ks[2], (DEPTH, D_MODEL), 0.02),
        "w_in": nrm(ks[3], (DEPTH, D_MODEL, IN_COLS), D_MODEL ** -0.5),
        "gate_bias": nrm(ks[4], (DEPTH, 2 * D_MODEL), 0.02),
        "lambda_q1": nrm(ks[5], (DEPTH, A_HEAD_DIM), 0.1),
        "lambda_k1": nrm(ks[6], (DEPTH, A_HEAD_DIM), 0.1),
        "lambda_q2": nrm(ks[7], (DEPTH, A_HEAD_DIM), 0.1),
        "lambda_k2": nrm(ks[8], (DEPTH, A_HEAD_DIM), 0.1),
        "subln": 1.0 + nrm(ks[9], (DEPTH, A_VDIM), 0.02),
        "sink": nrm(ks[10], (DEPTH, B_HEADS), 1.0),
        "w_proj_a": nrm(ks[11], (DEPTH, A_WIDTH, D_MODEL), A_WIDTH ** -0.5),
        "w_proj_b": nrm(ks[12], (DEPTH, B_WIDTH, D_MODEL), B_WIDTH ** -0.5),
        "w_out": nrm(ks[13], (DEPTH, D_MODEL, D_MODEL), D_MODEL ** -0.5),
        "ffn_norm": 1.0 + nrm(ks[14], (DEPTH, D_MODEL), 0.02),
        "w_up": nrm(ks[15], (DEPTH, D_MODEL, 2 * D_FF), D_MODEL ** -0.5),
        "conv_w": nrm(ks[16], (DEPTH, CONV_WIDTH, D_FF), 0.5),
        "conv_b": nrm(ks[17], (DEPTH, D_FF), 0.02),
        "w_down": nrm(ks[18], (DEPTH, D_FF, D_MODEL), D_FF ** -0.5),
        "final_norm": 1.0 + nrm(ks[19], (D_MODEL,), 0.02),
    }


def reference(x_prompt, x_sample, attn_norm, w_in, gate_bias, lambda_q1, lambda_k1, lambda_q2,
              lambda_k2, subln, sink, w_proj_a, w_proj_b, w_out, ffn_norm, w_up, conv_w, conv_b,
              w_down, final_norm):
    xp = x_prompt
    xs = x_sample
    for l in range(DEPTH):
        xp = trunk_layer(xp, l, attn_norm, w_in, gate_bias, lambda_q1, lambda_k1, lambda_q2,
                         lambda_k2, subln, sink, w_proj_a, w_proj_b, w_out, ffn_norm, w_up,
                         conv_w, conv_b, w_down)
        xs = trunk_layer(xs, l, attn_norm, w_in, gate_bias, lambda_q1, lambda_k1, lambda_q2,
                         lambda_k2, subln, sink, w_proj_a, w_proj_b, w_out, ffn_norm, w_up,
                         conv_w, conv_b, w_down)
    y_prompt = rmsnorm(xp, final_norm)
    y_sample = rmsnorm(xs, final_norm)
    return (y_prompt, y_sample)
```

```cpp
#include <hip/hip_runtime.h>
#include <hip/hip_cooperative_groups.h>
#include <cstdio>
#include <cstdint>
namespace cg = cooperative_groups;

#define LAS __attribute__((address_space(3)))
typedef unsigned short bf16_t;
typedef short bf16x8 __attribute__((ext_vector_type(8)));
typedef float f32x4 __attribute__((ext_vector_type(4)));
typedef float f32x16 __attribute__((ext_vector_type(16)));
typedef unsigned u32x4 __attribute__((ext_vector_type(4)));
#define GAS __attribute__((address_space(1)))
typedef GAS bf16_t gbf;
typedef GAS float gfl;
typedef GAS unsigned char gu8;
typedef GAS unsigned long long gu64;

__device__ __forceinline__ unsigned cvt_pk_bf16(float lo, float hi) { unsigned r; asm("v_cvt_pk_bf16_f32 %0, %1, %2" : "=v"(r) : "v"(lo), "v"(hi)); return r; }
__device__ __forceinline__ int opaque_v(int v) { asm volatile("" : "+v"(v)); return v; }
template <class T> __device__ __forceinline__ T* uni(T* p) {
    const unsigned long long v = (unsigned long long)p; const unsigned lo = __builtin_amdgcn_readfirstlane((unsigned)v), hi = __builtin_amdgcn_readfirstlane((unsigned)(v >> 32));
    return (T*)(((unsigned long long)hi << 32) | lo); }
__device__ __forceinline__ float unif(float v) { return __int_as_float(__builtin_amdgcn_readfirstlane(__float_as_int(v))); }
__device__ __forceinline__ float bf_lo(unsigned w) { return __uint_as_float(w << 16); }
__device__ __forceinline__ float bf_hi(unsigned w) { return __uint_as_float(w & 0xffff0000u); }
template <int M> __device__ __forceinline__ float swz_xor(float v) { return __int_as_float(__builtin_amdgcn_ds_swizzle(__float_as_int(v), 0x1f | (M << 10))); }
__device__ __forceinline__ float sum_x32(float v) { auto rr = __builtin_amdgcn_permlane32_swap(__float_as_uint(v), __float_as_uint(v), false, false); return __uint_as_float(rr[0]) + __uint_as_float(rr[1]); }
__device__ __forceinline__ float max_x32(float v) { auto rr = __builtin_amdgcn_permlane32_swap(__float_as_uint(v), __float_as_uint(v), false, false); return __builtin_fmaxf(__uint_as_float(rr[0]), __uint_as_float(rr[1])); }
__device__ __forceinline__ float sum_row32(float v) { v += swz_xor<1>(v); v += swz_xor<2>(v); v += swz_xor<4>(v); v += swz_xor<8>(v); v += swz_xor<16>(v); return v; }
__device__ __forceinline__ float wave_sum(float v) { return sum_x32(sum_row32(v)); }
__device__ __forceinline__ float nopack(float v) { asm("" : "+v"(v)); return v; }
__device__ __forceinline__ float max3f(float a, float b, float c) { float r; asm("v_max3_f32 %0, %1, %2, %3" : "=v"(r) : "v"(a), "v"(b), "v"(c)); return r; }
__device__ __forceinline__ float max2f(float a, float b) { float r; asm("v_max_f32_e32 %0, %1, %2" : "=v"(r) : "v"(a), "v"(b)); return r; }
template <int CTRL> __device__ __forceinline__ float dpp_self(float v) { return __int_as_float(__builtin_amdgcn_update_dpp(__float_as_int(v), __float_as_int(v), CTRL, 0xf, 0xf, false)); }
__device__ __forceinline__ float wave_max_uniform(float v) {
    v = max2f(v, dpp_self<0x121>(v)); v = max2f(v, dpp_self<0x122>(v)); v = max2f(v, dpp_self<0x124>(v)); v = max2f(v, dpp_self<0x128>(v));
    const float a = __int_as_float(__builtin_amdgcn_readlane(__float_as_int(v), 0)), b = __int_as_float(__builtin_amdgcn_readlane(__float_as_int(v), 16)),
                c = __int_as_float(__builtin_amdgcn_readlane(__float_as_int(v), 32)), d = __int_as_float(__builtin_amdgcn_readlane(__float_as_int(v), 48));
    return __builtin_fmaxf(__builtin_fmaxf(a, b), __builtin_fmaxf(c, d));
}
template <int CTRL> __device__ __forceinline__ float dpp_mov(float v) { return __int_as_float(__builtin_amdgcn_update_dpp(0, __float_as_int(v), CTRL, 0xf, 0xf, false)); }

constexpr int DM = 1024, MG = 65536;
constexpr int NPROJ = 3840;
constexpr int C_QA = 0, C_KA = 512, C_QB = 1024, C_GA = 1536, C_GB = 2560, C_KB = 3584;
constexpr int NVT = 768;
constexpr int DFF = 2816, NUP = 5632;
constexpr float QSCALE = 0.125f * 1.4426950408889634f;
constexpr float LOG2E = 1.4426950408889634f;
constexpr float EPS = 1e-6f;

constexpr size_t MiB = 1u << 20;
constexpr size_t WS_W = 0, W_LAYER = 32 * MiB;
constexpr size_t W_W1T = 0, W_WVT = 7864320, W_WPA = 9437184, W_WPB = 10485760, W_WOUT = 11534336, W_WUP = 13631488, W_WDOWN = 25165824;
constexpr size_t WS_HB = 64 * MiB, WS_PROJ = 192 * MiB, WS_VT = 672 * MiB, WS_Y = 768 * MiB, WS_G = 192 * MiB, WS_END = 896 * MiB;
constexpr size_t WS_Q = 31 * MiB + 640 * 1024;
constexpr size_t WS_KN2 = 31 * MiB + 512 * 1024;
constexpr size_t WS_SSA = 30 * MiB, WS_SSB = 30 * MiB + 512 * 1024;

namespace pg8 {
constexpr int BM = 256, BK = 64, HALF = 128, HTB = HALF * BK * 2, STAGE_BYTES = 8 * HTB, NXCD = 8, WGM = 8;
__host__ __device__ __forceinline__ int lds_byte(int r, int c) { const int st = (r >> 4) * 2 + (c >> 5), rr = r & 15, cc = c & 31, ob = rr * 64 + cc * 2; return st * 1024 + (ob ^ (((ob >> 9) & 1) << 5)); }
__host__ __device__ __forceinline__ void stage_rc(int b, int& R, int& C) { const int st = b / 1024, sb = b % 1024, swz = sb ^ (((sb >> 9) & 1) << 5); R = (st >> 1) * 16 + swz / 64; C = (st & 1) * 32 + (swz % 64) / 2; }
__host__ __device__ __forceinline__ int perm32(int rho) { const int n = rho >> 4, i = rho & 15; return 8 * (i >> 2) + 4 * n + (i & 3); }

struct Unit { int pm, pn; };
struct Gemm { const gbf* A; const gbf* Bt; int M, N, K, lda, ldb; };

struct StaticOrder {
    int nM, nN, nwg, G, c;
    __device__ void init(int M, int N, int G_, int c_) { nM = M / BM; nN = N / BM; nwg = nM * nN; G = G_; c = c_; }
    __device__ void init_tiles(int nM_, int nN_, int G_, int c_) { nM = nM_; nN = nN_; nwg = nM * nN; G = G_; c = c_; }
    __device__ bool next(int i, Unit& u) const {
        const long L = (long)i * G + c; if (L >= nwg) return false;
        int wgid = (int)L; { const int q = nwg / NXCD, r = nwg % NXCD, xcd = wgid % NXCD, off = wgid / NXCD; wgid = (xcd < r ? xcd * (q + 1) : r * (q + 1) + (xcd - r) * q) + off; }
        const int nig = WGM * nN, gid = wgid / nig, fm = gid * WGM, gsz = (nM - fm) < WGM ? (nM - fm) : WGM;
        u.pm = fm + ((wgid % nig) % gsz); u.pn = (wgid % nig) / gsz; return true;
    }
};

struct EpiStoreBf16 {
    static constexpr bool PERM = true;
    gbf* O; size_t ldc;
    __device__ __forceinline__ void operator()(const f32x4 (&acc)[2][2][4][2], const Unit& u, int wr, int wc, int fr, int fq) const {
        const int row0 = u.pm * BM + wr * 64 + fr, col0 = u.pn * BM + wc * 32 + 8 * fq;
#pragma unroll
        for (int ai = 0; ai < 2; ++ai)
#pragma unroll
            for (int m = 0; m < 4; ++m) { gbf* rowp = O + (size_t)(row0 + ai * HALF + m * 16) * ldc + col0;
#pragma unroll
                for (int bj = 0; bj < 2; ++bj) { const f32x4 v0 = acc[ai][bj][m][0], v1 = acc[ai][bj][m][1];
                    u32x4 w; w.x = cvt_pk_bf16(v0[0], v0[1]); w.y = cvt_pk_bf16(v0[2], v0[3]); w.z = cvt_pk_bf16(v1[0], v1[1]); w.w = cvt_pk_bf16(v1[2], v1[3]);
                    *(GAS u32x4*)(rowp + bj * HALF) = w; } }
    }
};
template <bool ACCUM> struct EpiGate {
    static constexpr bool PERM = true;
    gbf* O; int ldc; const gbf* G; int ldg; const gfl* bias;
    __device__ __forceinline__ void operator()(const f32x4 (&acc)[2][2][4][2], const Unit& u, int wr, int wc, int fr, int fq) const {
        const int row0 = u.pm * BM + wr * 64 + fr, col0 = u.pn * BM + wc * 32 + 8 * fq;
#pragma unroll
        for (int bj = 0; bj < 2; ++bj) {
            const f32x4 b0 = *(const GAS f32x4*)(bias + col0 + bj * HALF), b1 = *(const GAS f32x4*)(bias + col0 + bj * HALF + 4);
#pragma unroll
            for (int ai = 0; ai < 2; ++ai) {
                u32x4 gwv[4], owv[4];
#pragma unroll
                for (int m = 0; m < 4; ++m) { const size_t row = (size_t)(row0 + ai * HALF + m * 16);
                    gwv[m] = *(const GAS u32x4*)(G + row * ldg + col0 + bj * HALF);
                    if (ACCUM) owv[m] = *(const GAS u32x4*)(O + row * ldc + col0 + bj * HALF); }
#pragma unroll
                for (int m = 0; m < 4; ++m) { const size_t row = (size_t)(row0 + ai * HALF + m * 16);
                    const u32x4 gw = gwv[m];
                    gbf* op = O + row * ldc + col0 + bj * HALF;
                    float z[8] = {bf_lo(gw.x) + b0[0], bf_hi(gw.x) + b0[1], bf_lo(gw.y) + b0[2], bf_hi(gw.y) + b0[3], bf_lo(gw.z) + b1[0], bf_hi(gw.z) + b1[1], bf_lo(gw.w) + b1[2], bf_hi(gw.w) + b1[3]};
                    const f32x4 v0 = acc[ai][bj][m][0], v1 = acc[ai][bj][m][1];
                    float a[8] = {v0[0], v0[1], v0[2], v0[3], v1[0], v1[1], v1[2], v1[3]};
                    float r[8];
#pragma unroll
                    for (int i = 0; i < 8; ++i) r[i] = a[i] * __builtin_amdgcn_rcpf(1.f + __builtin_amdgcn_exp2f(-LOG2E * z[i]));
                    if (ACCUM) { const u32x4 ow = owv[m];
                        r[0] += bf_lo(ow.x); r[1] += bf_hi(ow.x); r[2] += bf_lo(ow.y); r[3] += bf_hi(ow.y); r[4] += bf_lo(ow.z); r[5] += bf_hi(ow.z); r[6] += bf_lo(ow.w); r[7] += bf_hi(ow.w); }
                    u32x4 w; w.x = cvt_pk_bf16(r[0], r[1]); w.y = cvt_pk_bf16(r[2], r[3]); w.z = cvt_pk_bf16(r[4], r[5]); w.w = cvt_pk_bf16(r[6], r[7]);
                    *(GAS u32x4*)op = w; }
            }
        }
    }
};
struct EpiResid {
    static constexpr bool PERM = false;
    const gfl* base; gfl* out; int ldc;
    __device__ __forceinline__ void operator()(const f32x4 (&acc)[2][2][4][2], const Unit& u, int wr, int wc, int fr, int fq) const {
        const int row0 = u.pm * BM + wr * 64 + fr, col0 = u.pn * BM + wc * 32 + 4 * fq;
#pragma unroll
        for (int ai = 0; ai < 2; ++ai)
#pragma unroll
            for (int m = 0; m < 4; ++m) { const size_t off = (size_t)(row0 + ai * HALF + m * 16) * ldc + col0;
#pragma unroll
                for (int bj = 0; bj < 2; ++bj)
#pragma unroll
                    for (int n = 0; n < 2; ++n) { const f32x4 bs = *(const GAS f32x4*)(base + off + bj * HALF + n * 16); *(GAS f32x4*)(out + off + bj * HALF + n * 16) = bs + acc[ai][bj][m][n]; } }
    }
};

__device__ __forceinline__ float rstd_of(unsigned long long ssq) { return __builtin_amdgcn_rsqf((float)ssq * (1.f / (1024.f * 1048576.f)) + EPS); }
struct EpiStoreRow {
    static constexpr bool PERM = true;
    gbf* O; size_t ldc; const gu64* ssq; GAS unsigned* kn2; int S;
    __device__ __forceinline__ void operator()(const f32x4 (&acc)[2][2][4][2], const Unit& u, int wr, int wc, int fr, int fq) const {
        const int row0 = u.pm * BM + wr * 64 + fr, col0 = u.pn * BM + wc * 32 + 8 * fq;
        const bool ktile = (u.pn == 2 || u.pn == 3);
        float mxsq[2] = {0.f, 0.f};
        float rsv[2][4];
        if (ssq) { unsigned long long q[2][4];
#pragma unroll
            for (int ai = 0; ai < 2; ++ai)
#pragma unroll
                for (int m = 0; m < 4; ++m) q[ai][m] = ssq[row0 + ai * HALF + m * 16];
#pragma unroll
            for (int ai = 0; ai < 2; ++ai)
#pragma unroll
                for (int m = 0; m < 4; ++m) rsv[ai][m] = rstd_of(q[ai][m]);
        } else {
#pragma unroll
            for (int ai = 0; ai < 2; ++ai)
#pragma unroll
                for (int m = 0; m < 4; ++m) rsv[ai][m] = 1.f; }
#pragma unroll
        for (int ai = 0; ai < 2; ++ai)
#pragma unroll
            for (int m = 0; m < 4; ++m) { const int row = row0 + ai * HALF + m * 16; gbf* rowp = O + (size_t)row * ldc + col0;
                const float rs = rsv[ai][m];
#pragma unroll
                for (int bj = 0; bj < 2; ++bj) { const f32x4 v0 = acc[ai][bj][m][0] * rs, v1 = acc[ai][bj][m][1] * rs;
                    u32x4 w; w.x = cvt_pk_bf16(v0[0], v0[1]); w.y = cvt_pk_bf16(v0[2], v0[3]); w.z = cvt_pk_bf16(v1[0], v1[1]); w.w = cvt_pk_bf16(v1[2], v1[3]);
                    *(GAS u32x4*)(rowp + bj * HALF) = w;
                    if (ktile) { float q = (v0[0] * v0[0] + v0[1] * v0[1]) + (v0[2] * v0[2] + v0[3] * v0[3]) + (v1[0] * v1[0] + v1[1] * v1[1]) + (v1[2] * v1[2] + v1[3] * v1[3]);
                        q += swz_xor<16>(q); q = sum_x32(q); mxsq[bj] = __builtin_fmaxf(mxsq[bj], q); } } }
        if (ktile) {
#pragma unroll
            for (int bj = 0; bj < 2; ++bj) { float q = mxsq[bj];
                q = __builtin_fmaxf(q, swz_xor<1>(q)); q = __builtin_fmaxf(q, swz_xor<2>(q)); q = __builtin_fmaxf(q, swz_xor<4>(q)); q = __builtin_fmaxf(q, swz_xor<8>(q));
                if (fr == 0 && fq == 0) { const int b = (u.pm * BM) / S, grp = (u.pn - 2) * 8 + bj * 4 + wc;
                    (void)__hip_atomic_fetch_max(kn2 + b * 16 + grp, __float_as_uint(q), __ATOMIC_RELAXED, __HIP_MEMORY_SCOPE_AGENT); } }
        }
    }
};
struct EpiStoreCol {
    static constexpr bool PERM = true;
    gbf* O; size_t ldc; const gu64* ssq;
    __device__ __forceinline__ void operator()(const f32x4 (&acc)[2][2][4][2], const Unit& u, int wr, int wc, int fr, int fq) const {
        const int row0 = u.pm * BM + wr * 64 + fr, col0 = u.pn * BM + wc * 32 + 8 * fq;
        f32x4 cs[2][2];
#pragma unroll
        for (int bj = 0; bj < 2; ++bj)
#pragma unroll
            for (int n = 0; n < 2; ++n) { if (ssq) { const gu64* q = ssq + col0 + bj * HALF + 4 * n; cs[bj][n] = (f32x4){rstd_of(q[0]), rstd_of(q[1]), rstd_of(q[2]), rstd_of(q[3])}; } else cs[bj][n] = (f32x4){1.f, 1.f, 1.f, 1.f}; }
#pragma unroll
        for (int ai = 0; ai < 2; ++ai)
#pragma unroll
            for (int m = 0; m < 4; ++m) { gbf* rowp = O + (size_t)(row0 + ai * HALF + m * 16) * ldc + col0;
#pragma unroll
                for (int bj = 0; bj < 2; ++bj) { const f32x4 v0 = acc[ai][bj][m][0] * cs[bj][0], v1 = acc[ai][bj][m][1] * cs[bj][1];
                    u32x4 w; w.x = cvt_pk_bf16(v0[0], v0[1]); w.y = cvt_pk_bf16(v0[2], v0[3]); w.z = cvt_pk_bf16(v1[0], v1[1]); w.w = cvt_pk_bf16(v1[2], v1[3]);
                    *(GAS u32x4*)(rowp + bj * HALF) = w; } }
    }
};
struct EpiResidNorm {
    static constexpr bool PERM = false;
    const gfl* base; gfl* out; int ldc; gbf* xb; const gfl* gn; gu64* ssq; bool do_norm;
    __device__ __forceinline__ void operator()(const f32x4 (&acc)[2][2][4][2], const Unit& u, int wr, int wc, int fr, int fq) const {
        typedef unsigned u32x2 __attribute__((ext_vector_type(2)));
        fr = opaque_v(fr); fq = opaque_v(fq);
        const int row0 = u.pm * BM + wr * 64 + fr, col0 = u.pn * BM + wc * 32 + 4 * fq;
        f32x4 gv[2][2];
#pragma unroll
        for (int bj = 0; bj < 2; ++bj)
#pragma unroll
            for (int n = 0; n < 2; ++n) gv[bj][n] = do_norm ? *(const GAS f32x4*)(gn + col0 + bj * HALF + n * 16) : (f32x4){0.f, 0.f, 0.f, 0.f};
#pragma unroll
        for (int ai = 0; ai < 2; ++ai)
#pragma unroll
            for (int mh = 0; mh < 2; ++mh) {
                f32x4 bsv[2][2][2];
#pragma unroll
                for (int mm = 0; mm < 2; ++mm) { const size_t off = (size_t)(row0 + ai * HALF + (2 * mh + mm) * 16) * ldc + col0;
#pragma unroll
                    for (int bj = 0; bj < 2; ++bj)
#pragma unroll
                        for (int n = 0; n < 2; ++n) bsv[mm][bj][n] = *(const GAS f32x4*)(base + off + bj * HALF + n * 16); }
#pragma unroll
                for (int mm = 0; mm < 2; ++mm) { const int m = 2 * mh + mm, row = row0 + ai * HALF + m * 16; const size_t off = (size_t)row * ldc + col0; float sq = 0.f;
#pragma unroll
                    for (int bj = 0; bj < 2; ++bj)
#pragma unroll
                        for (int n = 0; n < 2; ++n) { const f32x4 v = bsv[mm][bj][n] + acc[ai][bj][m][n]; *(GAS f32x4*)(out + off + bj * HALF + n * 16) = v;
                            if (do_norm) { sq += (v[0] * v[0] + v[1] * v[1]) + (v[2] * v[2] + v[3] * v[3]); const f32x4 w = v * gv[bj][n];
                                u32x2 pk; pk.x = cvt_pk_bf16(w[0], w[1]); pk.y = cvt_pk_bf16(w[2], w[3]); *(GAS u32x2*)(xb + off + bj * HALF + n * 16) = pk; } }
                    if (do_norm) { sq += swz_xor<16>(sq); sq = sum_x32(sq); if (fq == 0) (void)__hip_atomic_fetch_add(ssq + row, (unsigned long long)(sq * 1048576.f + 0.5f), __ATOMIC_RELAXED, __HIP_MEMORY_SCOPE_AGENT); } }
            }
    }
};
struct EpiConv {
    static constexpr bool PERM = true;
    gbf* Gout; const gu64* ssq; const gfl* cw; const gfl* cb; LAS float* xch; int S, M;
    __device__ __forceinline__ void operator()(const f32x4 (&acc)[2][2][4][2], const Unit& u, int wr, int wc, int fr, int fq) const {
        fr = opaque_v(fr); fq = opaque_v(fq);
        const int out_lo = u.pm * 254; int base = out_lo - 1; base = base < 0 ? 0 : base; base = base > M - 256 ? M - 256 : base;
        const int out_hi = out_lo + 254 < M ? out_lo + 254 : M;
        const int colh = wc * 32 + 8 * fq, f0 = u.pn * 128 + colh;
        float w0[8], w1[8], w2[8], bb[8];
        { const f32x4 a0 = *(const GAS f32x4*)(cw + f0), a1 = *(const GAS f32x4*)(cw + f0 + 4), b0 = *(const GAS f32x4*)(cw + DFF + f0), b1 = *(const GAS f32x4*)(cw + DFF + f0 + 4),
                      c0 = *(const GAS f32x4*)(cw + 2 * DFF + f0), c1 = *(const GAS f32x4*)(cw + 2 * DFF + f0 + 4), d0 = *(const GAS f32x4*)(cb + f0), d1 = *(const GAS f32x4*)(cb + f0 + 4);
#pragma unroll
          for (int k = 0; k < 4; ++k) { w0[k] = a0[k]; w0[4 + k] = a1[k]; w1[k] = b0[k]; w1[4 + k] = b1[k]; w2[k] = c0[k]; w2[4 + k] = c1[k]; bb[k] = d0[k]; bb[4 + k] = d1[k]; } }
        float rs[2][4];
#pragma unroll
        for (int ai = 0; ai < 2; ++ai)
#pragma unroll
            for (int m = 0; m < 4; ++m) rs[ai][m] = __builtin_bit_cast(float, 0);
        { unsigned long long q[2][4];
#pragma unroll
          for (int ai = 0; ai < 2; ++ai)
#pragma unroll
              for (int m = 0; m < 4; ++m) q[ai][m] = ssq[base + ai * HALF + wr * 64 + m * 16 + fr];
#pragma unroll
          for (int ai = 0; ai < 2; ++ai)
#pragma unroll
              for (int m = 0; m < 4; ++m) rs[ai][m] = rstd_of(q[ai][m]); }
#pragma unroll
        for (int ai = 0; ai < 2; ++ai) {
            const bool isf = fr == 0; LAS float* d = xch + ((ai * 2 + wr) * 2 + (isf ? 0 : 1)) * 128 + colh;
#pragma unroll
            for (int k = 0; k < 8; ++k) { const float vf = acc[ai][0][0][k >> 2][k & 3] * rs[ai][0], vl = acc[ai][0][3][k >> 2][k & 3] * rs[ai][3];
                float v; asm("v_cndmask_b32 %0, %1, %2, %3" : "=v"(v) : "v"(vl), "v"(vf), "s"(__builtin_amdgcn_ballot_w64(isf)));
                if (fr == 0 || fr == 15) d[k] = v; }
        }
        asm volatile("s_waitcnt lgkmcnt(0)" ::: "memory"); __builtin_amdgcn_s_barrier(); asm volatile("" ::: "memory");
#pragma unroll
        for (int ai = 0; ai < 2; ++ai)
#pragma unroll
            for (int m = 0; m < 4; ++m) {
                const int chunk = ai * 2 + wr, row = base + ai * HALF + wr * 64 + m * 16 + fr, pos = row & (S - 1);
                float gsv[8];
#pragma unroll
                for (int k = 0; k < 8; ++k) {
                    const float am = acc[ai][0][m][k >> 2][k & 3] * rs[ai][m];
                    float sp, sn;
                    if (m > 0) sp = fr == 15 ? acc[ai][0][m - 1][k >> 2][k & 3] * rs[ai][m - 1] : am; else sp = am;
                    if (m < 3) sn = fr == 0 ? acc[ai][0][m + 1][k >> 2][k & 3] * rs[ai][m + 1] : am; else sn = am;
                    float pv = dpp_mov<0x121>(sp), nv = dpp_mov<0x12F>(sn);
                    if (m == 0) { const float e = chunk > 0 ? xch[((chunk - 1) * 2 + 1) * 128 + colh + k] : 0.f; pv = fr == 0 ? e : pv; }
                    if (m == 3) { const float e = chunk < 3 ? xch[((chunk + 1) * 2 + 0) * 128 + colh + k] : 0.f; nv = fr == 15 ? e : nv; }
                    pv = pos == 0 ? 0.f : pv; nv = pos == S - 1 ? 0.f : nv;
                    const float c = pv * w0[k] + am * w1[k] + nv * w2[k] + bb[k];
                    const float ge = c * __builtin_amdgcn_rcpf(1.f + __builtin_amdgcn_exp2f(c * __builtin_fmaf(-0.10294324f, c * c, -2.3022082f)));
                    gsv[k] = ge * (acc[ai][1][m][k >> 2][k & 3] * rs[ai][m]);
                }
                if (row >= out_lo && row < out_hi) {
                    u32x4 w; w.x = cvt_pk_bf16(gsv[0], gsv[1]); w.y = cvt_pk_bf16(gsv[2], gsv[3]); w.z = cvt_pk_bf16(gsv[4], gsv[5]); w.w = cvt_pk_bf16(gsv[6], gsv[7]);
                    *(GAS u32x4*)(Gout + (size_t)row * DFF + f0) = w; }
            }
    }
};

template <class Epi, class Sched, bool ALIGN_EPI, int ASTEP = 256>
__device__ __forceinline__ void gemm_phase(LAS unsigned char* lds, const Gemm g, const Sched& S, const Epi& E, const int tid) {
    const int wid = __builtin_amdgcn_readfirstlane(tid >> 6), lane = tid & 63, wr = wid >> 2, wc = wid & 3, fr = lane & 15, fq = lane >> 4;
    const int K = g.K, nt = K / BK;
    unsigned voffA[2], voffB[2];
#pragma unroll
    for (int i = 0; i < 2; ++i) { int R, C; stage_rc(tid * 16 + i * 8192, R, C); const int Rb = Epi::PERM ? ((R & ~31) + perm32(R & 31)) : R;
        voffA[i] = (unsigned)(R * g.lda + C) * 2u; voffB[i] = (unsigned)(Rb * g.ldb + C) * 2u; }
    const size_t kstep = (size_t)(BK * 2);
    const size_t hstepA = (size_t)HALF * g.lda * 2, hstepB = (size_t)HALF * g.ldb * 2;
    const size_t tstepB = 2 * hstepB;
#define PG8_ABASE(pm) ((const GAS char*)g.A + (size_t)(ASTEP == 256 ? (pm) * 256 : (((pm) * ASTEP - 1) < 0 ? 0 : (((pm) * ASTEP - 1) > g.M - 256 ? g.M - 256 : ((pm) * ASTEP - 1)))) * g.lda * 2)
    const unsigned ldsw = (unsigned)wid * 1024u;
    const int aoff = lds_byte(wr * 64 + fr, fq * 8), boff = lds_byte(wc * 32 + fr, fq * 8);
#define PG8_SA(b, h) (((b) * 2 + (h)) * HTB)
#define PG8_SB(b, h) ((4 + (b) * 2 + (h)) * HTB)
#define PG8_STAGE(bufoff, gbase, voff) do { _Pragma("unroll") for (int _i = 0; _i < 2; ++_i) \
        __builtin_amdgcn_global_load_lds((const GAS unsigned*)((const GAS char*)(gbase) + (voff)[_i]), (LAS unsigned*)(lds + (bufoff) + ldsw + _i * 8192), 16, 0, 0); } while (0)
#define PG8_LDA(dst, b, h) do { _Pragma("unroll") for (int m = 0; m < 4; ++m) _Pragma("unroll") for (int k = 0; k < 2; ++k) dst[m][k] = *(const LAS bf16x8*)(lds + PG8_SA(b, h) + aoff + m * 2048 + k * 1024); } while (0)
#define PG8_LDB(dst, b, h) do { _Pragma("unroll") for (int n = 0; n < 2; ++n) _Pragma("unroll") for (int k = 0; k < 2; ++k) dst[n][k] = *(const LAS bf16x8*)(lds + PG8_SB(b, h) + boff + n * 2048 + k * 1024); } while (0)
#define PG8_MMA(ai, bj, At, Bt) do { __builtin_amdgcn_s_setprio(1); _Pragma("unroll") for (int m = 0; m < 4; ++m) _Pragma("unroll") for (int n = 0; n < 2; ++n) _Pragma("unroll") for (int k = 0; k < 2; ++k) \
        acc[ai][bj][m][n] = __builtin_amdgcn_mfma_f32_16x16x32_bf16(Bt[n][k], At[m][k], acc[ai][bj][m][n], 0, 0, 0); __builtin_amdgcn_s_setprio(0); } while (0)
#define PG8_WAIT_V(n) asm volatile("s_waitcnt vmcnt(" #n ")" ::: "memory")
#define PG8_WAIT_L(n) asm volatile("s_waitcnt lgkmcnt(" #n ")" ::: "memory")
#define PG8_BAR __builtin_amdgcn_s_barrier()
#define PG8_SCHED __builtin_amdgcn_sched_barrier(0)
    Unit cur, nxt; int ui = 0;
    if (!S.next(0, cur)) return;
    f32x4 acc[2][2][4][2];
#pragma unroll
    for (int a = 0; a < 2; ++a)
#pragma unroll
        for (int b = 0; b < 2; ++b)
#pragma unroll
            for (int m = 0; m < 4; ++m)
#pragma unroll
                for (int n = 0; n < 2; ++n) acc[a][b][m][n] = (f32x4){0.f, 0.f, 0.f, 0.f};
    bf16x8 At[4][2], B0[2][2], B1[2][2];
    const GAS char* cA = PG8_ABASE(cur.pm); const GAS char* cB = (const GAS char*)g.Bt + (size_t)cur.pn * tstepB;
    PG8_STAGE(PG8_SB(0, 0), cB, voffB); PG8_STAGE(PG8_SB(0, 1), cB + hstepB, voffB); PG8_STAGE(PG8_SA(0, 0), cA, voffA); PG8_STAGE(PG8_SA(0, 1), cA + hstepA, voffA);
    if (wr == 1) PG8_BAR;
    PG8_WAIT_V(2); PG8_BAR;
    PG8_STAGE(PG8_SB(1, 0), cB + kstep, voffB); PG8_STAGE(PG8_SA(1, 0), cA + kstep, voffA); PG8_STAGE(PG8_SB(1, 1), cB + hstepB + kstep, voffB);
    PG8_WAIT_V(6); PG8_BAR;
    for (;;) {
        const bool has_next = S.next(ui + 1, nxt);
        const GAS char* nA = has_next ? PG8_ABASE(nxt.pm) : cA; const GAS char* nB = has_next ? (const GAS char*)g.Bt + (size_t)nxt.pn * tstepB : cB;
        for (int t = 0; t < nt; t += 2) {
            const bool last = (t == nt - 2);
            const GAS char* a1 = cA + (size_t)(t + 1) * kstep;
            const GAS char* a2 = last ? nA : cA + (size_t)(t + 2) * kstep; const GAS char* b2 = last ? nB : cB + (size_t)(t + 2) * kstep;
            const GAS char* a3 = a2 + kstep; const GAS char* b3 = b2 + kstep;
            PG8_LDB(B0, 0, 0); PG8_LDB(B1, 0, 1); PG8_SCHED; PG8_LDA(At, 0, 0); PG8_STAGE(PG8_SA(1, 1), a1 + hstepA, voffA);
            PG8_WAIT_V(8); PG8_WAIT_L(0); PG8_BAR; PG8_MMA(0, 0, At, B0); PG8_MMA(0, 1, At, B1); PG8_BAR; PG8_SCHED;
            PG8_LDA(At, 0, 1); PG8_STAGE(PG8_SB(0, 0), b2, voffB); PG8_STAGE(PG8_SB(0, 1), b2 + hstepB, voffB); PG8_STAGE(PG8_SA(0, 0), a2, voffA);
            PG8_WAIT_V(8); PG8_WAIT_L(0); PG8_BAR; PG8_MMA(1, 0, At, B0); PG8_MMA(1, 1, At, B1); PG8_BAR; PG8_SCHED;
            PG8_LDB(B0, 1, 0); PG8_LDB(B1, 1, 1); PG8_SCHED; PG8_LDA(At, 1, 0); PG8_STAGE(PG8_SA(0, 1), a2 + hstepA, voffA);
            PG8_WAIT_V(8); PG8_WAIT_L(0); PG8_BAR; PG8_MMA(0, 0, At, B0); PG8_MMA(0, 1, At, B1); PG8_BAR; PG8_SCHED;
            PG8_LDA(At, 1, 1); PG8_STAGE(PG8_SB(1, 0), b3, voffB); PG8_STAGE(PG8_SB(1, 1), b3 + hstepB, voffB); PG8_STAGE(PG8_SA(1, 0), a3, voffA);
            PG8_WAIT_V(8); PG8_WAIT_L(0); PG8_BAR; PG8_MMA(1, 0, At, B0); PG8_MMA(1, 1, At, B1); PG8_BAR; PG8_SCHED;
        }
        if constexpr (ALIGN_EPI) { if (wr == 0) PG8_BAR; }
        E(acc, cur, wr, wc, fr, fq);
        if (!has_next) break;
#pragma unroll
        for (int a = 0; a < 2; ++a)
#pragma unroll
            for (int b = 0; b < 2; ++b)
#pragma unroll
                for (int m = 0; m < 4; ++m)
#pragma unroll
                    for (int n = 0; n < 2; ++n) acc[a][b][m][n] = (f32x4){0.f, 0.f, 0.f, 0.f};
        cur = nxt; cA = nA; cB = nB; ++ui;
        if constexpr (ALIGN_EPI) { if (wr == 1) PG8_BAR; }
    }
    PG8_WAIT_V(0);
    if constexpr (!ALIGN_EPI) { if (wr == 0) PG8_BAR; }
    PG8_BAR;
#undef PG8_ABASE
#undef PG8_SA
#undef PG8_SB
#undef PG8_STAGE
#undef PG8_LDA
#undef PG8_LDB
#undef PG8_MMA
#undef PG8_WAIT_V
#undef PG8_WAIT_L
#undef PG8_BAR
#undef PG8_SCHED
}
}

namespace att {
__device__ __forceinline__ int swap23(int r) { return (r & ~12) | ((r & 4) << 1) | ((r & 8) >> 1); }
__device__ __forceinline__ int crow(int r, int hi) { return (r & 3) + 8 * (r >> 2) + 4 * hi; }

template <int NDV, bool MASK, int KPITCH, int VPITCH>
__device__ __forceinline__ void wave_tile(const LAS char* kp, const LAS char* vp, const bf16x8 (&qf)[4], f32x16 (&o)[NDV], float& mref, float& lsum,
                                          const float dbase, const float nslope, LAS float* wsf, const int r32, const int hi) {
    f32x16 s0, s1;
#pragma unroll
    for (int r = 0; r < 16; ++r) { s0[r] = 0.f; s1[r] = 0.f; }
#pragma unroll
    for (int dc = 0; dc < 4; ++dc) {
        const bf16x8 a0 = *(const LAS bf16x8*)(kp + dc * 32);
        const bf16x8 a1 = *(const LAS bf16x8*)(kp + 32 * KPITCH + dc * 32);
        s0 = __builtin_amdgcn_mfma_f32_32x32x16_bf16(a0, qf[dc], s0, 0, 0, 0);
        s1 = __builtin_amdgcn_mfma_f32_32x32x16_bf16(a1, qf[dc], s1, 0, 0, 0);
    }
    float mx = -3.0e38f;
#pragma unroll
    for (int r = 0; r < 16; ++r) {
        const float c = (float)((r & 7) + 16 * (r >> 3));
        const float d0 = __builtin_fabsf(dbase + c), d1 = __builtin_fabsf(dbase + (c + 32.f));
        float t0 = __builtin_fmaf(nslope, d0, s0[r]), t1 = __builtin_fmaf(nslope, d1, s1[r]);
        if (MASK) { t0 = d0 <= 128.f ? t0 : -1e30f; t1 = d1 <= 128.f ? t1 : -1e30f; }
        s0[r] = t0; s1[r] = t1; mx = __builtin_fmaxf(mx, __builtin_fmaxf(t0, t1));
    }
    mx = max_x32(mx);
    if (__any(mx > mref + 8.f)) {
        const float mnew = __builtin_fmaxf(mref, mx); const float alpha = __builtin_amdgcn_exp2f(mref - mnew);
        lsum *= alpha; mref = mnew;
        if (hi == 0) wsf[r32] = alpha;
#pragma unroll
        for (int r = 0; r < 16; ++r) { const float al = wsf[crow(r, hi)];
#pragma unroll
            for (int d = 0; d < NDV; ++d) o[d][r] *= al; }
    }
    float rs = 0.f;
#pragma unroll
    for (int r = 0; r < 16; ++r) { s0[r] = __builtin_amdgcn_exp2f(s0[r] - mref); s1[r] = __builtin_amdgcn_exp2f(s1[r] - mref); rs += s0[r] + s1[r]; }
    lsum += rs;
    bf16x8 pa[4];
    { u32x4 w;
      w.x = cvt_pk_bf16(s0[0], s0[1]); w.y = cvt_pk_bf16(s0[2], s0[3]); w.z = cvt_pk_bf16(s0[4], s0[5]); w.w = cvt_pk_bf16(s0[6], s0[7]); pa[0] = __builtin_bit_cast(bf16x8, w);
      w.x = cvt_pk_bf16(s0[8], s0[9]); w.y = cvt_pk_bf16(s0[10], s0[11]); w.z = cvt_pk_bf16(s0[12], s0[13]); w.w = cvt_pk_bf16(s0[14], s0[15]); pa[1] = __builtin_bit_cast(bf16x8, w);
      w.x = cvt_pk_bf16(s1[0], s1[1]); w.y = cvt_pk_bf16(s1[2], s1[3]); w.z = cvt_pk_bf16(s1[4], s1[5]); w.w = cvt_pk_bf16(s1[6], s1[7]); pa[2] = __builtin_bit_cast(bf16x8, w);
      w.x = cvt_pk_bf16(s1[8], s1[9]); w.y = cvt_pk_bf16(s1[10], s1[11]); w.z = cvt_pk_bf16(s1[12], s1[13]); w.w = cvt_pk_bf16(s1[14], s1[15]); pa[3] = __builtin_bit_cast(bf16x8, w); }
#pragma unroll
    for (int d = 0; d < NDV; ++d)
#pragma unroll
        for (int c = 0; c < 4; ++c) {
            const bf16x8 vf = *(const LAS bf16x8*)(vp + d * 32 * VPITCH + c * 32);
            o[d] = __builtin_amdgcn_mfma_f32_32x32x16_bf16(pa[c], vf, o[d], 0, 0, 0);
        }
}

constexpr int A_KP = 272, A_VP = 144, A_KBYTES = 64 * A_KP, A_VBYTES = 128 * A_VP, A_BUF = A_KBYTES + A_VBYTES;
constexpr int B_KP = 144, B_VP = 144, B_KBYTES = 64 * B_KP, B_VBYTES = 64 * B_VP, B_BUF = B_KBYTES + B_VBYTES;
constexpr int WSF_OFF = 2 * A_BUF;
constexpr int ATT_LDS = WSF_OFF + 8 * 256;

template <int TYPE>
__device__ __forceinline__ void wave_tileA(const LAS char* lds, const int (&kad)[4], const int (&vad)[4], const bf16x8 (&qf)[4], f32x16 (&o)[4], float& mref, float& lsum,
                                           const float dbase, const float nslope, LAS float* wsf, const int r32, const int hi, const bool first, const bool chk) {
    f32x16 s0, s1;
    if (TYPE == 2) {
#pragma unroll
        for (int r = 0; r < 16; ++r) { const float c = (float)((r & 7) + 16 * (r >> 3));
            s0[r] = __builtin_fmaf(nslope, __builtin_fabsf(dbase + c), -mref); s1[r] = __builtin_fmaf(nslope, __builtin_fabsf(dbase + (c + 32.f)), -mref); }
    } else {
        const float sg = nslope, bl = __builtin_fmaf(sg, dbase, -mref);
#pragma unroll
        for (int r = 0; r < 16; ++r) { const float c = (float)((r & 7) + 16 * (r >> 3)); s0[r] = nopack(__builtin_fmaf(sg, c, bl)); s1[r] = nopack(__builtin_fmaf(sg, c + 32.f, bl)); }
    }
#pragma unroll
    for (int dc = 0; dc < 4; ++dc) {
        const bf16x8 a0 = *(const LAS bf16x8*)(lds + kad[dc]);
        const bf16x8 a1 = *(const LAS bf16x8*)(lds + kad[dc] + 8192);
        s0 = __builtin_amdgcn_mfma_f32_32x32x16_bf16(a0, qf[dc], s0, 0, 0, 0);
        s1 = __builtin_amdgcn_mfma_f32_32x32x16_bf16(a1, qf[dc], s1, 0, 0, 0);
    }
    if (chk) {
    asm volatile("s_nop 15\n\ts_nop 7" : "+v"(s0), "+v"(s1));
    float mx = max3f(s0[0], s1[0], s0[1]), mx2 = max3f(s1[1], s0[2], s1[2]);
#pragma unroll
    for (int r = 3; r < 15; r += 2) { mx = max3f(mx, s0[r], s1[r]); mx2 = max3f(mx2, s0[r + 1], s1[r + 1]); }
    mx = max3f(mx, s0[15], s1[15]); mx = max2f(mx, mx2);
    mx = max_x32(mx);
    if (first || __any(mx > 8.f)) {
        const float dl = first ? mx : __builtin_fmaxf(mx, 0.f), alpha = __builtin_amdgcn_exp2f(-dl);
        lsum *= alpha; mref += dl;
#pragma unroll
        for (int r = 0; r < 16; ++r) { s0[r] -= dl; s1[r] -= dl; }
        if (hi == 0) wsf[r32] = alpha;
#pragma unroll
        for (int r = 0; r < 16; ++r) { const float al = wsf[crow(r, hi)];
#pragma unroll
            for (int d = 0; d < 4; ++d) o[d][r] *= al; }
    }
    }
    float rsa = 0.f, rsb = 0.f;
#pragma unroll
    for (int r = 0; r < 16; ++r) { s0[r] = nopack(__builtin_amdgcn_exp2f(s0[r])); s1[r] = nopack(__builtin_amdgcn_exp2f(s1[r])); rsa = nopack(rsa + s0[r]); rsb = nopack(rsb + s1[r]); }
    lsum += rsa + rsb;
    bf16x8 pa[4];
    { u32x4 w;
      w.x = cvt_pk_bf16(s0[0], s0[1]); w.y = cvt_pk_bf16(s0[2], s0[3]); w.z = cvt_pk_bf16(s0[4], s0[5]); w.w = cvt_pk_bf16(s0[6], s0[7]); pa[0] = __builtin_bit_cast(bf16x8, w);
      w.x = cvt_pk_bf16(s0[8], s0[9]); w.y = cvt_pk_bf16(s0[10], s0[11]); w.z = cvt_pk_bf16(s0[12], s0[13]); w.w = cvt_pk_bf16(s0[14], s0[15]); pa[1] = __builtin_bit_cast(bf16x8, w);
      w.x = cvt_pk_bf16(s1[0], s1[1]); w.y = cvt_pk_bf16(s1[2], s1[3]); w.z = cvt_pk_bf16(s1[4], s1[5]); w.w = cvt_pk_bf16(s1[6], s1[7]); pa[2] = __builtin_bit_cast(bf16x8, w);
      w.x = cvt_pk_bf16(s1[8], s1[9]); w.y = cvt_pk_bf16(s1[10], s1[11]); w.z = cvt_pk_bf16(s1[12], s1[13]); w.w = cvt_pk_bf16(s1[14], s1[15]); pa[3] = __builtin_bit_cast(bf16x8, w); }
#pragma unroll
    for (int d = 0; d < 4; ++d)
#pragma unroll
        for (int c = 0; c < 4; ++c) {
            const bf16x8 vf = *(const LAS bf16x8*)(lds + vad[c] + d * 4096);
            o[d] = __builtin_amdgcn_mfma_f32_32x32x16_bf16(pa[c], vf, o[d], 0, 0, 0);
        }
}

constexpr int A_STAGE = 32768, A_NSTAGE = 4, A_VOFF = 16384;
constexpr int WSFA_OFF = A_STAGE * A_NSTAGE;
constexpr int LIM_OFF = WSFA_OFF + 8 * 256;
constexpr int ATT_LDS2 = LIM_OFF + 128;
constexpr float SKIP_MARGIN = 136.f;

__device__ __forceinline__ void unitA(LAS char* lds, const gbf* PROJ, const gbf* VT, gbf* Y, const int S, const int tok0, const int h, const int qblk,
                                      const float lam, const float oml, const gfl* subln, const float kn2a, const float kn2b, const int tid_) {
    const int tid = opaque_v(tid_);
    const int lane = tid & 63, r32 = lane & 31, hi = lane >> 5, wid = __builtin_amdgcn_readfirstlane(tid >> 6), rg = wid >> 1, map = wid & 1;
    const int NT = S >> 6, tstart = qblk * 2;
    const int q0 = qblk * 128 + rg * 32;
    const float slope2 = LOG2E * __builtin_amdgcn_exp2f(-2.f * (float)(h + 1)), nslope = -slope2, inv_slope2 = 1.f / slope2;
    const bool skip_en = slope2 * (float)S > SKIP_MARGIN + 8.f;
    LAS float* wsf = (LAS float*)(lds + WSFA_OFF) + wid * 64;
    LAS float* lim = (LAS float*)(lds + LIM_OFF);
    asm volatile("s_waitcnt vmcnt(0)" ::: "memory");
    const gbf* ksrc[2]; const gbf* vsrc[2];
#pragma unroll
    for (int i = 0; i < 2; ++i) { const int j = 2 * wid + i;
        { const int row = 4 * j + (lane >> 4), c = (lane & 15) ^ (row & 15); ksrc[i] = PROJ + (size_t)(tok0 + row) * NPROJ + C_KA + h * 128 + c * 8; }
        { const int row = 8 * j + (lane >> 3), c = (lane & 7) ^ ((row >> 1) & 7); vsrc[i] = VT + (size_t)(h * 128 + row) * MG + tok0 + c * 8; } }
#define A_ISSUE(tile, stage) do { const int kv0_ = (tile) * 64; LAS char* sb_ = lds + (stage) * A_STAGE + wid * 2048; \
        __builtin_amdgcn_global_load_lds((const GAS unsigned*)(ksrc[0] + (size_t)kv0_ * NPROJ), (LAS unsigned*)(sb_), 16, 0, 0); \
        __builtin_amdgcn_global_load_lds((const GAS unsigned*)(ksrc[1] + (size_t)kv0_ * NPROJ), (LAS unsigned*)(sb_ + 1024), 16, 0, 0); \
        __builtin_amdgcn_global_load_lds((const GAS unsigned*)(vsrc[0] + kv0_), (LAS unsigned*)(sb_ + A_VOFF), 16, 0, 0); \
        __builtin_amdgcn_global_load_lds((const GAS unsigned*)(vsrc[1] + kv0_), (LAS unsigned*)(sb_ + A_VOFF + 1024), 16, 0, 0); } while (0)
    bf16x8 qf[4];
    { const gbf* qp = PROJ + (size_t)(tok0 + q0 + r32) * NPROJ + C_QA + h * 128 + map * 64 + hi * 8;
#pragma unroll
      for (int dc = 0; dc < 4; ++dc) qf[dc] = *(const GAS bf16x8*)(qp + dc * 16); }
    float blkR = 3.0e38f, blkL = -3.0e38f;
    float ew = 3.0e38f;
    const int NT2 = NT >> 1, tstart2 = qblk;
    int dir = 1, tlast = tstart2;
#define A_GEN(dst) do { int tn_; \
        if (dir > 0) { tn_ = tlast + 1; if (tn_ >= NT2 || (float)(tn_ * 128) > blkR) { dir = -1; tn_ = tstart2 - 1; if (tn_ < 0 || (float)(tn_ * 128 + 127) < blkL) tn_ = -1; } } \
        else { tn_ = tlast - 1; if (tn_ < 0 || (float)(tn_ * 128 + 127) < blkL) tn_ = -1; } \
        if (tn_ >= 0) tlast = tn_; dst = tn_; } while (0)
    int tA = tstart2, tB;
    A_ISSUE(2 * tA, 0); A_ISSUE(2 * tA + 1, 1);
    float ub;
    { float qn = 0.f;
#pragma unroll
      for (int dc = 0; dc < 4; ++dc) { const u32x4 w = __builtin_bit_cast(u32x4, qf[dc]);
          qn += bf_lo(w.x) * bf_lo(w.x) + bf_hi(w.x) * bf_hi(w.x) + bf_lo(w.y) * bf_lo(w.y) + bf_hi(w.y) * bf_hi(w.y) + bf_lo(w.z) * bf_lo(w.z) + bf_hi(w.z) * bf_hi(w.z) + bf_lo(w.w) * bf_lo(w.w) + bf_hi(w.w) * bf_hi(w.w); }
      qn = sum_x32(qn);
      ub = __builtin_sqrtf(qn * ((map ? kn2b : kn2a) * 1.03f)) * 1.002f + 0.05f; }
    f32x16 o[4];
#pragma unroll
    for (int d = 0; d < 4; ++d)
#pragma unroll
        for (int r = 0; r < 16; ++r) o[d][r] = 0.f;
    float mref = 0.f, lsum = 0.f;
    int kbase[4], vbase[4];
    { const int krow = swap23(r32), km = krow & 15, vm = (r32 >> 1) & 7;
#pragma unroll
      for (int dc = 0; dc < 4; ++dc) kbase[dc] = krow * 256 + (((map * 8 + dc * 2 + hi) ^ km) << 4);
#pragma unroll
      for (int c = 0; c < 4; ++c) vbase[c] = A_VOFF + r32 * 128 + (((2 * c + hi) ^ vm) << 4); }
    const float qposf = (float)(q0 + r32 - 8 * hi);
    for (int it = 0;; ++it) {
        asm volatile("s_waitcnt vmcnt(0) lgkmcnt(0)\n\ts_barrier" ::: "memory");
        if (skip_en && it > 0) { const LAS f32x4* lp = (const LAS f32x4*)(lim + ((it - 1) & 1) * 16); const f32x4 a = lp[0], b = lp[1], c = lp[2], d = lp[3];
            blkR = __builtin_fmaxf(__builtin_fmaxf(__builtin_fmaxf(a[0], a[2]), __builtin_fmaxf(b[0], b[2])), __builtin_fmaxf(__builtin_fmaxf(c[0], c[2]), __builtin_fmaxf(d[0], d[2])));
            blkL = __builtin_fminf(__builtin_fminf(__builtin_fminf(a[1], a[3]), __builtin_fminf(b[1], b[3])), __builtin_fminf(__builtin_fminf(c[1], c[3]), __builtin_fminf(d[1], d[3])));
            blkR = unif(blkR); blkL = unif(blkL); }
        A_GEN(tB); if (tB >= 0) { A_ISSUE(2 * tB, 2 * ((it + 1) & 1)); A_ISSUE(2 * tB + 1, 2 * ((it + 1) & 1) + 1); }
#pragma unroll
        for (int sub = 0; sub < 2; ++sub) {
          const int kv0 = tA * 128 + sub * 64, sb = (2 * (it & 1) + sub) * A_STAGE; const float dbase = (float)kv0 - qposf;
          int kad[4], vad[4];
#pragma unroll
          for (int k = 0; k < 4; ++k) { kad[k] = kbase[k] + sb; vad[k] = vbase[k] + sb; }
          const int dmin = kv0 > q0 ? kv0 - (q0 + 31) : q0 - (kv0 + 63);
          const bool frst = it == 0 && sub == 0;
          const bool chk = frst || !(ew - slope2 * (float)dmin < 7.5f);
          if (kv0 + 63 < q0 || kv0 > q0 + 31) wave_tileA<0>(lds, kad, vad, qf, o, mref, lsum, dbase, kv0 > q0 ? nslope : -nslope, wsf, r32, hi, frst, chk);
          else wave_tileA<2>(lds, kad, vad, qf, o, mref, lsum, dbase, nslope, wsf, r32, hi, frst, true); }
        if (skip_en || (it & 1) == 0) ew = wave_max_uniform(ub - mref);
        if (skip_en) {
            const float e = ew;
            const float R = (e + SKIP_MARGIN) * inv_slope2;
            if (lane == 0) { lim[(it & 1) * 16 + wid * 2] = (float)(q0 + 31) + R; lim[(it & 1) * 16 + wid * 2 + 1] = (float)q0 - R; }
        }
        if (tB < 0) break;
        tA = tB;
    }
#undef A_ISSUE
#undef A_GEN
    asm volatile("s_waitcnt lgkmcnt(0)\n\ts_barrier" ::: "memory");
    float inv = 1.f / sum_x32(lsum);
    if (map == 1) inv *= lam;
    if (hi == 0) wsf[r32] = inv;
    float invr[16];
#pragma unroll
    for (int r = 0; r < 16; ++r) invr[r] = wsf[crow(r, hi)];
    LAS float* X = (LAS float*)lds + rg * 4096;
    if (map == 1) {
#pragma unroll
        for (int d = 0; d < 4; ++d)
#pragma unroll
            for (int r = 0; r < 16; ++r) X[(d * 16 + r) * 64 + lane] = o[d][r] * invr[r];
    }
    __syncthreads();
    if (map == 0) {
        const int r32e = opaque_v(r32);
        float sub[4];
#pragma unroll
        for (int d = 0; d < 4; ++d) sub[d] = subln[d * 32 + r32e] * oml;
#pragma unroll
        for (int r = 0; r < 16; ++r) {
            float ss = 0.f;
#pragma unroll
            for (int d = 0; d < 4; ++d) { const float v = o[d][r] * invr[r] - X[(d * 16 + r) * 64 + lane]; o[d][r] = v; ss += v * v; }
            ss = sum_row32(ss);
            const float rstd = __builtin_amdgcn_rsqf(ss * (1.f / 128.f) + EPS);
            gbf* yp = Y + (size_t)(tok0 + q0 + crow(r, hi)) * DM + h * 128 + r32e;
#pragma unroll
            for (int d = 0; d < 4; ++d) yp[d * 32] = (bf16_t)(cvt_pk_bf16(o[d][r] * rstd * sub[d], 0.f) & 0xffffu);
        }
    }
    __syncthreads();
}

__device__ __forceinline__ void unitB(LAS char* lds, const gbf* PROJ, const gbf* VT, gbf* Y, const int S, const int tok0, const int kvh, const int qblk, const gfl* sink, const int tid) {
    const int lane = tid & 63, r32 = lane & 31, hi = lane >> 5, wid = __builtin_amdgcn_readfirstlane(tid >> 6), gh = wid >> 1, sub = wid & 1;
    const int hq = kvh * 4 + gh;
    const int q0 = qblk * 64 + sub * 32;
    const float nslope = -LOG2E * __builtin_amdgcn_exp2f(-(float)(hq + 1));
    LAS float* wsf = (LAS float*)(lds + 131072) + wid * 64;
    const int NT = S >> 6;
    const int tlo = qblk - 2 < 0 ? 0 : qblk - 2, thi = qblk + 2 > NT - 1 ? NT - 1 : qblk + 2;
    const int srow = tid >> 3, sch = tid & 7;
    const gbf* ksrc = PROJ + (size_t)(tok0 + srow) * NPROJ + C_KB + kvh * 64 + sch * 8;
    const gbf* vsrc = VT + (size_t)(512 + kvh * 64 + srow) * MG + tok0 + sch * 8;
    const int kdst = srow * B_KP + sch * 16, vdst = B_KBYTES + srow * B_VP + sch * 16;
    bf16x8 qf[4];
    { const gbf* qp = PROJ + (size_t)(tok0 + q0 + r32) * NPROJ + C_QB + hq * 64 + hi * 8;
#pragma unroll
      for (int dc = 0; dc < 4; ++dc) qf[dc] = *(const GAS bf16x8*)(qp + dc * 16); }
    f32x16 o[2];
#pragma unroll
    for (int d = 0; d < 2; ++d)
#pragma unroll
        for (int r = 0; r < 16; ++r) o[d][r] = 0.f;
    float mref = sink[hq] * LOG2E, lsum = hi == 0 ? 1.f : 0.f;
    u32x4 kreg[5], vreg[5];
#pragma unroll
    for (int i = 0; i < 5; ++i) if (tlo + i <= thi) { kreg[i] = *(const GAS u32x4*)(ksrc + (size_t)((tlo + i) * 64) * NPROJ); vreg[i] = *(const GAS u32x4*)(vsrc + (tlo + i) * 64); }
#pragma unroll
    for (int i = 0; i < 5; ++i) if (tlo + i <= thi) { *(LAS u32x4*)(lds + i * B_BUF + kdst) = kreg[i]; *(LAS u32x4*)(lds + i * B_BUF + vdst) = vreg[i]; }
    __syncthreads();
    const int kpo = swap23(r32) * B_KP + hi * 16, vpo = B_KBYTES + r32 * B_VP + hi * 16;
    const float qposf = (float)(q0 + r32 - 8 * hi);
    for (int t = tlo; t <= thi; ++t) {
        const int bo = (t - tlo) * B_BUF;
        wave_tile<2, true, B_KP, B_VP>(lds + bo + kpo, lds + bo + vpo, qf, o, mref, lsum, (float)(t * 64) - qposf, nslope, wsf, r32, hi);
    }
    __syncthreads();
    const float inv = 1.f / sum_x32(lsum);
    if (hi == 0) wsf[r32] = inv;
#pragma unroll
    for (int r = 0; r < 16; ++r) { const float ir = wsf[crow(r, hi)];
        gbf* yp = Y + (size_t)(tok0 + q0 + crow(r, hi)) * DM + 512 + hq * 64 + r32;
#pragma unroll
        for (int d = 0; d < 2; ++d) yp[d * 32] = (bf16_t)(cvt_pk_bf16(o[d][r] * ir, 0.f) & 0xffffu); }
}
}

__device__ __forceinline__ void cvt_item(const gfl* W, int ldw, int k0, int n0, gbf* WT, int ldk, int drow0, float scale, LAS float* scr, int lane) {
#pragma unroll 8
    for (int i = 0; i < 32; ++i) { const int kk = 2 * i + (lane >> 5); scr[kk * 33 + (lane & 31)] = W[(size_t)(k0 + kk) * ldw + n0 + (lane & 31)]; }
    asm volatile("s_waitcnt lgkmcnt(0)" ::: "memory");
    const int c = lane & 7;
#pragma unroll
    for (int j = 0; j < 4; ++j) { const int n = (lane >> 3) + 8 * j; const LAS float* s = scr + (8 * c) * 33 + n;
        u32x4 o; o.x = cvt_pk_bf16(s[0 * 33] * scale, s[1 * 33] * scale); o.y = cvt_pk_bf16(s[2 * 33] * scale, s[3 * 33] * scale); o.z = cvt_pk_bf16(s[4 * 33] * scale, s[5 * 33] * scale); o.w = cvt_pk_bf16(s[6 * 33] * scale, s[7 * 33] * scale);
        *(GAS u32x4*)(WT + (size_t)(drow0 + n) * ldk + k0 + 8 * c) = o; }
    asm volatile("s_waitcnt lgkmcnt(0)" ::: "memory");
}
__device__ __forceinline__ bool cvt_seg(int& r, const gfl* W, int K, int ldw, int c0, int ncols, gbf* WT, int drow0, float scale, LAS float* scr, int lane, bool upperm = false) {
    const int nb = ncols / 32, cnt = (K / 64) * nb;
    if (r < cnt) { const int kb = r / nb, b = r % nb; int dr = drow0 + b * 32;
        if (upperm) { const int n = b * 32; dr = n < DFF ? 256 * (n / 128) + (n % 128) : 256 * ((n - DFF) / 128) + 128 + ((n - DFF) % 128); }
        cvt_item(W, ldw, kb * 64, c0 + b * 32, WT, K, dr, scale, scr, lane); return true; }
    r -= cnt; return false;
}

struct Params { const float* in[20]; float* out; unsigned char* ws; };
typedef const __attribute__((address_space(4))) Params* KP;

__device__ __forceinline__ void convert_weights(KP pk, LAS unsigned char* lds, int gw, int NGW, int wave, int lane) {
    LAS float* scr = (LAS float*)(lds + wave * 16384);
    constexpr int PER_LAYER = 16 * ((NPROJ + NVT) / 32) + 8 * 32 * 2 + 16 * 32 + 16 * (NUP / 32) + 44 * 32;
    for (int it = gw; it < 2 * PER_LAYER; it += NGW) {
        const int l = it / PER_LAYER; int r = it % PER_LAYER;
        gu8* wb = (gu8*)pk->ws + WS_W + (size_t)l * W_LAYER;
        gbf* W1T = (gbf*)(wb + W_W1T); gbf* WVT = (gbf*)(wb + W_WVT);
        const gfl* win = ((const gfl*)pk->in[3]) + (size_t)l * 1024 * 4352;
        if (cvt_seg(r, win, 1024, 4352, 0, 512, W1T, C_QA, QSCALE, scr, lane)) continue;
        if (cvt_seg(r, win, 1024, 4352, 512, 512, W1T, C_KA, 1.f, scr, lane)) continue;
        if (cvt_seg(r, win, 1024, 4352, 1024, 512, WVT, 0, 1.f, scr, lane)) continue;
        if (cvt_seg(r, win, 1024, 4352, 1536, 512, W1T, C_QB, QSCALE, scr, lane)) continue;
        if (cvt_seg(r, win, 1024, 4352, 2048, 128, W1T, C_KB, 1.f, scr, lane)) continue;
        if (cvt_seg(r, win, 1024, 4352, 2048, 128, W1T, C_KB + 128, 1.f, scr, lane)) continue;
        if (cvt_seg(r, win, 1024, 4352, 2176, 128, WVT, 512, 1.f, scr, lane)) continue;
        if (cvt_seg(r, win, 1024, 4352, 2176, 128, WVT, 640, 1.f, scr, lane)) continue;
        if (cvt_seg(r, win, 1024, 4352, 2304, 1024, W1T, C_GA, 1.f, scr, lane)) continue;
        if (cvt_seg(r, win, 1024, 4352, 3328, 1024, W1T, C_GB, 1.f, scr, lane)) continue;
        if (cvt_seg(r, ((const gfl*)pk->in[11]) + (size_t)l * 512 * 1024, 512, 1024, 0, 1024, (gbf*)(wb + W_WPA), 0, 1.f, scr, lane)) continue;
        if (cvt_seg(r, ((const gfl*)pk->in[12]) + (size_t)l * 512 * 1024, 512, 1024, 0, 1024, (gbf*)(wb + W_WPB), 0, 1.f, scr, lane)) continue;
        if (cvt_seg(r, ((const gfl*)pk->in[13]) + (size_t)l * 1024 * 1024, 1024, 1024, 0, 1024, (gbf*)(wb + W_WOUT), 0, 1.f, scr, lane)) continue;
        if (cvt_seg(r, ((const gfl*)pk->in[15]) + (size_t)l * 1024 * NUP, 1024, NUP, 0, NUP, (gbf*)(wb + W_WUP), 0, 1.f, scr, lane, true)) continue;
        cvt_seg(r, ((const gfl*)pk->in[18]) + (size_t)l * DFF * 1024, DFF, 1024, 0, 1024, (gbf*)(wb + W_WDOWN), 0, 1.f, scr, lane);
    }
}

__device__ __forceinline__ void rms_phase(const gfl* x, const gfl* g, gbf* out, int gw, int NGW, int lane) {
    f32x4 gv[4];
#pragma unroll
    for (int j = 0; j < 4; ++j) gv[j] = ((const GAS f32x4*)g)[lane + 64 * j];
    for (int m = gw; m < MG; m += NGW) {
        const GAS f32x4* xr = (const GAS f32x4*)(x + (size_t)m * DM) + lane;
        f32x4 v[4]; float s = 0.f;
#pragma unroll
        for (int j = 0; j < 4; ++j) { v[j] = xr[64 * j]; s += (v[j].x * v[j].x + v[j].y * v[j].y) + (v[j].z * v[j].z + v[j].w * v[j].w); }
        const float rstd = __builtin_amdgcn_rsqf(wave_sum(s) * (1.f / DM) + EPS);
        GAS unsigned long long* o8 = (GAS unsigned long long*)(out + (size_t)m * DM) + lane;
#pragma unroll
        for (int j = 0; j < 4; ++j) { const f32x4 w = v[j] * rstd * gv[j]; o8[64 * j] = (unsigned long long)cvt_pk_bf16(w.x, w.y) | ((unsigned long long)cvt_pk_bf16(w.z, w.w) << 32); }
    }
}
__device__ __forceinline__ void final_norm_phase(gfl* x, const gfl* g, int gw, int NGW, int lane) {
    f32x4 gv[4];
#pragma unroll
    for (int j = 0; j < 4; ++j) gv[j] = ((const GAS f32x4*)g)[lane + 64 * j];
    for (int m = gw; m < MG; m += NGW) {
        GAS f32x4* xr = (GAS f32x4*)(x + (size_t)m * DM) + lane;
        f32x4 v[4]; float s = 0.f;
#pragma unroll
        for (int j = 0; j < 4; ++j) { v[j] = xr[64 * j]; s += (v[j].x * v[j].x + v[j].y * v[j].y) + (v[j].z * v[j].z + v[j].w * v[j].w); }
        const float rstd = __builtin_amdgcn_rsqf(wave_sum(s) * (1.f / DM) + EPS);
#pragma unroll
        for (int j = 0; j < 4; ++j) xr[64 * j] = v[j] * rstd * gv[j];
    }
}

__device__ __forceinline__ void unpack8(const u32x4 w, float (&f)[8]) { f[0] = bf_lo(w.x); f[1] = bf_hi(w.x); f[2] = bf_lo(w.y); f[3] = bf_hi(w.y); f[4] = bf_lo(w.z); f[5] = bf_hi(w.z); f[6] = bf_lo(w.w); f[7] = bf_hi(w.w); }
__device__ __forceinline__ void conv_phase(gbf* UP, const gfl* cw, const gfl* cb, int S, int gtid, int NT) {
    constexpr int NCC = DFF / 8, RUN = 32, NTASK = (MG / RUN) * NCC;
    for (int task = gtid; task < NTASK; task += NT) {
        const int cc = task % NCC, rr = task / NCC, f0 = cc * 8, row0 = rr * RUN, p0 = row0 & (S - 1);
        float w0[8], w1[8], w2[8], bb[8];
#pragma unroll
        for (int i = 0; i < 8; ++i) { w0[i] = cw[f0 + i]; w1[i] = cw[DFF + f0 + i]; w2[i] = cw[2 * DFF + f0 + i]; bb[i] = cb[f0 + i]; }
        const gbf* ap = UP + (size_t)row0 * NUP + f0;
        gbf* vp = UP + (size_t)row0 * NUP + DFF + f0;
        float prev[8], cur[8], nxt[8];
        if (p0 == 0) {
#pragma unroll
            for (int i = 0; i < 8; ++i) prev[i] = 0.f;
        } else unpack8(*(const GAS u32x4*)(ap - NUP), prev);
        unpack8(*(const GAS u32x4*)ap, cur);
        for (int r = 0; r < RUN; ++r) {
            if (p0 + r + 1 == S) {
#pragma unroll
                for (int i = 0; i < 8; ++i) nxt[i] = 0.f;
            } else unpack8(*(const GAS u32x4*)(ap + (size_t)(r + 1) * NUP), nxt);
            float vv[8]; unpack8(*(const GAS u32x4*)(vp + (size_t)r * NUP), vv);
            float gsv[8];
#pragma unroll
            for (int i = 0; i < 8; ++i) {
                const float c = prev[i] * w0[i] + cur[i] * w1[i] + nxt[i] * w2[i] + bb[i];
                const float u = 0.7978845608028654f * (c + 0.044715f * c * c * c);
                const float ge = c * __builtin_amdgcn_rcpf(1.f + __builtin_amdgcn_exp2f(-2.f * LOG2E * u));
                gsv[i] = ge * vv[i]; prev[i] = cur[i]; cur[i] = nxt[i];
            }
            u32x4 w; w.x = cvt_pk_bf16(gsv[0], gsv[1]); w.y = cvt_pk_bf16(gsv[2], gsv[3]); w.z = cvt_pk_bf16(gsv[4], gsv[5]); w.w = cvt_pk_bf16(gsv[6], gsv[7]);
            *(GAS u32x4*)(vp + (size_t)r * NUP) = w;
        }
    }
}

#define XB_TMO      128
#define XB_XCNT(j)  (256  + 64 * (j))
#define XB_XSUB(j)  (1280 + 64 * (j))
#define XB_XGEN(j)  (2304 + 64 * (j))
#define XB_TOP      3328
#define XB_TOPGEN   3392
#define XCD_BAR_WORDS 3456
#define XB_SPIN_CAP (1u << 22)
__device__ __forceinline__ unsigned xb_ld(unsigned* p)              { return __hip_atomic_load(p, __ATOMIC_RELAXED, __HIP_MEMORY_SCOPE_AGENT); }
__device__ __forceinline__ unsigned xb_add(unsigned* p, unsigned v) { return __hip_atomic_fetch_add(p, v, __ATOMIC_RELAXED, __HIP_MEMORY_SCOPE_AGENT); }
__device__ __forceinline__ unsigned xb_xcc_id() { return (unsigned)__builtin_amdgcn_s_getreg((3 << 11) | 20) & 0xFu; }
#define XB_SPIN(cond, bar) do { unsigned _sp = 0; while (cond) { __builtin_amdgcn_s_sleep(1); \
    if ((++_sp & 255u) == 0u) { if (xb_ld(&(bar)[XB_TMO])) break; if (_sp > XB_SPIN_CAP) { atomicAdd(&(bar)[XB_TMO], 1u); break; } } } } while (0)
struct XcdBarrier { unsigned* bar; unsigned x; volatile LAS unsigned* st; };
__device__ __forceinline__ void xcd_barrier_complete(unsigned* bar, unsigned x, unsigned& nloc, unsigned& nx) {
    const unsigned G = gridDim.x * gridDim.y * gridDim.z;
    unsigned sum, cnt, mine, sp = 0u;
    for (;;) {
        sum = 0u; cnt = 0u; mine = 0u;
#pragma unroll
        for (unsigned j = 0; j < 16; ++j) { const unsigned c = xb_ld(&bar[XB_XCNT(j)]); sum += c; cnt += (c > 0u) ? 1u : 0u; mine = (j == x) ? c : mine; }
        if (sum == G) break;
        __builtin_amdgcn_s_sleep(1);
        if ((++sp & 255u) == 0u) { if (xb_ld(&bar[XB_TMO])) break; if (sp > XB_SPIN_CAP) { atomicAdd(&bar[XB_TMO], 1u); break; } }
    }
    nloc = mine > 0u ? mine : 1u; nx = cnt > 0u ? cnt : 1u;
}
__device__ __forceinline__ void xcd_barrier(const XcdBarrier& b) {
    asm volatile("s_waitcnt vmcnt(0)" ::: "memory");
    __syncthreads();
    if (threadIdx.x == 0) {
        unsigned* bar = b.bar;
        __builtin_amdgcn_s_waitcnt(0);
        unsigned nloc = b.st[0], nx = b.st[1];
        if (nloc == 0u) { xcd_barrier_complete(bar, b.x, nloc, nx); b.st[0] = nloc; b.st[1] = nx; }
        const unsigned old = xb_add(&bar[XB_XSUB(b.x)], 1u);
        const unsigned gen = old / nloc;
        if (old + 1u == (gen + 1u) * nloc) {
            __builtin_amdgcn_fence(__ATOMIC_RELEASE, "agent");
            asm volatile("s_waitcnt vmcnt(0)" ::: "memory");
            const unsigned og = xb_add(&bar[XB_TOP], 1u);
            const unsigned tg = og / nx;
            if (og + 1u == (tg + 1u) * nx) xb_add(&bar[XB_TOPGEN], 1u);
            else XB_SPIN(xb_ld(&bar[XB_TOPGEN]) == tg, bar);
            __builtin_amdgcn_fence(__ATOMIC_ACQUIRE, "agent");
            xb_add(&bar[XB_XGEN(b.x)], 1u);
            asm volatile("s_waitcnt vmcnt(0)" ::: "memory");
        } else {
            XB_SPIN(xb_ld(&bar[XB_XGEN(b.x)]) == gen, bar);
            __builtin_amdgcn_fence(__ATOMIC_ACQUIRE, "agent");
            asm volatile("s_waitcnt vmcnt(0)" ::: "memory");
        }
    }
    __syncthreads();
}

constexpr int LDS_BYTES = 131072 + 4096 + 64;
constexpr int BARST_OFF = 131072 + 4096;
constexpr size_t WS_BAR = 31 * MiB + 768 * 1024;
static_assert(att::ATT_LDS2 <= LDS_BYTES, "attention LDS");
__device__ __forceinline__ KP kargs() { KP q = (KP)__builtin_amdgcn_kernarg_segment_ptr(); asm volatile("" : "+s"(q)); return q; }
__device__ __forceinline__ int opaque(int v) { asm volatile("" : "+s"(v)); return v; }
#define PHASE_COMMON \
    KP pp = kargs(); const int l = opaque(l_), g = opaque(g_); \
    const int wave = opaque(wave0_); const int lane = (int)__builtin_amdgcn_mbcnt_hi(~0u, __builtin_amdgcn_mbcnt_lo(~0u, (unsigned)opaque_v(0))); const int tid = wave * 64 + lane; \
    const int G = opaque((int)gridDim.x), bx = blockIdx.x; const int vcu = (G % 8 == 0) ? (bx % 8) * (G / 8) + bx / 8 : bx; const int gw = vcu * 8 + wave, NGW = G * 8; \
    gu8* ws = (gu8*)pp->ws; gu8* wb = ws + WS_W + (size_t)l * W_LAYER; \
    gbf* HB = (gbf*)(ws + WS_HB); gbf* PROJ = (gbf*)(ws + WS_PROJ); gbf* VT = (gbf*)(ws + WS_VT); gbf* Y = (gbf*)(ws + WS_Y); gbf* GB = (gbf*)(ws + WS_G); gu64* SSA = (gu64*)(ws + WS_SSA); gu64* SSB = (gu64*)(ws + WS_SSB); \
    const gfl* xin = (const gfl*)pp->in[g]; gfl* xo = (gfl*)pp->out + (size_t)g * MG * DM; const int S = g ? 8192 : 4096, NB = MG / S; \
    (void)lane; (void)wave; (void)vcu; (void)gw; (void)NGW; (void)wb; (void)HB; (void)PROJ; (void)VT; (void)Y; (void)GB; (void)SSA; (void)SSB; (void)xin; (void)xo; (void)S; (void)NB; (void)tid;

__global__ void __launch_bounds__(512, 2) mega_fwd(Params p) {
    extern __shared__ __attribute__((aligned(16))) unsigned char lds_raw[];
    LAS unsigned char* lds = (LAS unsigned char*)lds_raw;
    cg::grid_group grid = cg::this_grid();
    const int wave0_ = __builtin_amdgcn_readfirstlane((int)threadIdx.x >> 6);
    if (threadIdx.x < 2) ((LAS unsigned*)(lds + BARST_OFF))[threadIdx.x] = 0u;
    __syncthreads();
    if (threadIdx.x == 0) (void)xb_add((unsigned*)(kargs()->ws + WS_BAR) + XB_XCNT(xb_xcc_id()), 1u);
    grid.sync();
#define GBAR() do { XcdBarrier b_; b_.bar = (unsigned*)(kargs()->ws + WS_BAR); b_.x = xb_xcc_id(); b_.st = (volatile LAS unsigned*)(lds + BARST_OFF); xcd_barrier(b_); } while (0)
    { const int l_ = 0, g_ = 0; PHASE_COMMON
      if (bx == 0 && tid < 256) ((GAS unsigned*)(ws + WS_KN2))[tid] = 0u;
      if (bx == 0 && tid < 64) ((GAS unsigned*)(ws + WS_Q))[tid * 16] = 0u;
      convert_weights(pp, lds, gw, NGW, wave, lane); }

    for (int g_ = 0; g_ < 2; ++g_) {
        for (int l_ = 0; l_ < 2; ++l_) {
            if (l_ == 0) {
                { PHASE_COMMON
                  rms_phase(xin, ((const gfl*)pp->in[2]), HB, gw, NGW, lane); }
                GBAR();
            }
            { PHASE_COMMON
              pg8::Gemm gm{HB, (const gbf*)(wb + W_W1T), MG, NPROJ, DM, DM, DM}; pg8::StaticOrder so; so.init(MG, NPROJ, G, bx); pg8::EpiStoreRow E{PROJ, (size_t)NPROJ, l ? SSB : nullptr, (GAS unsigned*)(ws + WS_KN2), S};
              pg8::gemm_phase<pg8::EpiStoreRow, pg8::StaticOrder, true>(lds, gm, so, E, tid); }
            { PHASE_COMMON
              pg8::Gemm gm{(const gbf*)(wb + W_WVT), HB, NVT, MG, DM, DM, DM}; pg8::StaticOrder so; so.init(NVT, MG, G, bx); pg8::EpiStoreCol E{VT, (size_t)MG, l ? SSB : nullptr};
              pg8::gemm_phase<pg8::EpiStoreCol, pg8::StaticOrder, true>(lds, gm, so, E, tid); }
            GBAR();
            { PHASE_COMMON
              { gu64* z = (gu64*)(ws + WS_SSA); for (int i = bx * 512 + tid; i < 2 * MG; i += G * 512) z[i] = 0ull; }
              const float lam_init = l == 0 ? 0.2f : 0.35550906758f;
              float d1 = 0.f, d2 = 0.f;
              for (int i = 0; i < 64; ++i) { d1 += ((const gfl*)pp->in[5])[l * 64 + i] * ((const gfl*)pp->in[6])[l * 64 + i]; d2 += ((const gfl*)pp->in[7])[l * 64 + i] * ((const gfl*)pp->in[8])[l * 64 + i]; }
              const float lam = unif(__expf(d1) - __expf(d2) + lam_init);
              const int NQA = S / 128, nA = NB * 4 * NQA;
              const gfl* subln = uni(((const gfl*)pp->in[9]) + l * 128);
              const GAS unsigned* kn2 = uni((const GAS unsigned*)(ws + WS_KN2));
              const float oml = unif(1.f - lam_init);
              if (G == 256) {
                  LAS unsigned* qs = (LAS unsigned*)(lds + BARST_OFF + 16);
                  const unsigned xme = xb_xcc_id() & 7u;
                  for (unsigned sx = 0; sx < 8; ++sx) {
                      const unsigned x = (xme + sx) & 7u;
                      GAS unsigned* qh = (GAS unsigned*)(ws + WS_Q) + ((g * 2 + l) * 16 + (int)x) * 16;
                      for (;;) {
                          if (tid == 0) *qs = __hip_atomic_fetch_add(qh, 1u, __ATOMIC_RELAXED, __HIP_MEMORY_SCOPE_AGENT);
                          __syncthreads();
                          const unsigned j = (unsigned)__builtin_amdgcn_readfirstlane((int)*qs);
                          if (j >= 256u) { __syncthreads(); break; }
                          const int r = (int)(j >> 5), i = ((3 - (r >> 1)) & 3) + 4 * (r & 1), c = ((int)(j & 31u) + 4 * i) & 31, top = i >> 2, h = i & 3;
                          int b, qblk;
                          if (NQA == 32) { b = 2 * (int)x + top; qblk = c; } else { b = (int)x; qblk = c + 32 * top; }
                          const u32x4 kq = *(const GAS u32x4*)(kn2 + b * 16 + h * 4);
                          const float kn2a = __uint_as_float(kq.x) + __uint_as_float(kq.y), kn2b = __uint_as_float(kq.z) + __uint_as_float(kq.w);
                          att::unitA((LAS char*)lds, uni(PROJ), uni(VT), uni(Y), S, b * S, h, qblk, lam, oml, subln, unif(kn2a), unif(kn2b), tid);
                      }
                  }
              } else
              for (int u = vcu; u < nA; u += G) {
                  const int qblk = u & (NQA - 1), bh = u >> (NQA == 32 ? 5 : 6), h = bh & 3, b = bh >> 2;
                  const float kn2a = __uint_as_float(kn2[b * 16 + h * 4 + 0]) + __uint_as_float(kn2[b * 16 + h * 4 + 1]), kn2b = __uint_as_float(kn2[b * 16 + h * 4 + 2]) + __uint_as_float(kn2[b * 16 + h * 4 + 3]);
                  att::unitA((LAS char*)lds, uni(PROJ), uni(VT), uni(Y), S, b * S, h, qblk, lam, oml, subln, unif(kn2a), unif(kn2b), tid); } }
            { PHASE_COMMON
              const int NQB = S / 64, nB = NB * 2 * NQB;
              const gfl* sink = ((const gfl*)pp->in[10]) + l * 8;
              for (int u = vcu; u < nB; u += G) { const int qblk = u % NQB, bk = u / NQB, kvh = bk & 1, b = bk >> 1;
                  att::unitB((LAS char*)lds, PROJ, VT, Y, S, b * S, kvh, qblk, sink, tid); } }
            GBAR();
            { PHASE_COMMON
              pg8::Gemm gm{Y, (const gbf*)(wb + W_WPA), MG, DM, 512, DM, 512}; pg8::StaticOrder so; so.init(MG, DM, G, bx); pg8::EpiGate<false> E{HB, DM, PROJ + C_GA, NPROJ, ((const gfl*)pp->in[4]) + l * 2048};
              pg8::gemm_phase<pg8::EpiGate<false>, pg8::StaticOrder, true>(lds, gm, so, E, tid); }
            { PHASE_COMMON
              pg8::Gemm gm{Y + 512, (const gbf*)(wb + W_WPB), MG, DM, 512, DM, 512}; pg8::StaticOrder so; so.init(MG, DM, G, bx); pg8::EpiGate<true> E{HB, DM, PROJ + C_GB, NPROJ, ((const gfl*)pp->in[4]) + l * 2048 + 1024};
              pg8::gemm_phase<pg8::EpiGate<true>, pg8::StaticOrder, true>(lds, gm, so, E, tid); }
            GBAR();
            { PHASE_COMMON
              pg8::Gemm gm{HB, (const gbf*)(wb + W_WOUT), MG, DM, DM, DM, DM}; pg8::StaticOrder so; so.init(MG, DM, G, bx);
              if (bx == 0 && tid < 256) ((GAS unsigned*)(ws + WS_KN2))[tid] = 0u;
              pg8::EpiResidNorm E{l == 0 ? xin : xo, xo, DM, Y, ((const gfl*)pp->in[14]) + l * DM, SSA, true};
              pg8::gemm_phase<pg8::EpiResidNorm, pg8::StaticOrder, true>(lds, gm, so, E, tid); }
            GBAR();
            { PHASE_COMMON
              pg8::Gemm gm{uni(Y), uni((const gbf*)(wb + W_WUP)), MG, NUP, DM, DM, DM}; pg8::StaticOrder so; so.init_tiles((MG + 253) / 254, NUP / 256, G, bx);
              pg8::EpiConv E{uni(GB), uni(SSA), uni(((const gfl*)pp->in[16]) + (size_t)l * 3 * DFF), uni(((const gfl*)pp->in[17]) + (size_t)l * DFF), (LAS float*)(lds + 131072), S, MG};
              pg8::gemm_phase<pg8::EpiConv, pg8::StaticOrder, true, 254>(lds, gm, so, E, tid); }
            GBAR();
            { PHASE_COMMON
              pg8::Gemm gm{GB, (const gbf*)(wb + W_WDOWN), MG, DM, DFF, DFF, DFF}; pg8::StaticOrder so; so.init(MG, DM, G, bx);
              pg8::EpiResidNorm E{xo, xo, DM, HB, ((const gfl*)pp->in[2]) + DM, SSB, l == 0};
              pg8::gemm_phase<pg8::EpiResidNorm, pg8::StaticOrder, true>(lds, gm, so, E, tid); }
            GBAR();
        }
        { const int l_ = 0; PHASE_COMMON
          final_norm_phase(xo, ((const gfl*)pp->in[19]), gw, NGW, lane); }
    }
}

extern "C" void kernel_launch(void* const* d_in, const int* in_sizes, int n_in, void* d_out, int out_size, void* d_ws, size_t ws_size, hipStream_t stream) {
    static int grid = 0;
    if (grid == 0) {
        if (n_in != 20 || ws_size < WS_END) { fprintf(stderr, "kernel_launch: need 20 inputs and >= %zu bytes of workspace (got %d, %zu)\n", (size_t)WS_END, n_in, ws_size); grid = -1; return; }
        int dev = 0, cus = 0, per_cu = 0;
        hipGetDevice(&dev); hipDeviceGetAttribute(&cus, hipDeviceAttributeMultiprocessorCount, dev);
        if (hipFuncSetAttribute((const void*)mega_fwd, hipFuncAttributeMaxDynamicSharedMemorySize, LDS_BYTES) != hipSuccess) { fprintf(stderr, "kernel_launch: hipFuncSetAttribute failed\n"); grid = -1; return; }
        hipOccupancyMaxActiveBlocksPerMultiprocessor(&per_cu, (const void*)mega_fwd, 512, LDS_BYTES);
        (void)hipGetLastError();
        if (per_cu < 1) fprintf(stderr, "kernel_launch: occupancy query says %d blocks per CU\n", per_cu);
        grid = cus;
    }
    if (grid < 0) return;
    if (hipMemsetAsync((char*)d_ws + WS_BAR, 0, 16384, stream) != hipSuccess) { fprintf(stderr, "kernel_launch: hipMemsetAsync failed\n"); return; }
    Params p{};
    for (int i = 0; i < 20; ++i) p.in[i] = (const float*)d_in[i];
    p.out = (float*)d_out; p.ws = (unsigned char*)d_ws;
    void* args[] = {&p};
    hipError_t e = hipLaunchCooperativeKernel((const void*)mega_fwd, dim3(grid), dim3(512), args, LDS_BYTES, stream);
    if (e != hipSuccess) fprintf(stderr, "cooperative launch failed: %s (grid %d)\n", hipGetErrorString(e), grid);
}
```

```cpp
#include <hip/hip_runtime.h>
#include <hip/hip_cooperative_groups.h>
#include <cstdio>
#include <cstdint>
namespace cg = cooperative_groups;

#define LAS __attribute__((address_space(3)))
typedef unsigned short bf16_t;
typedef short bf16x8 __attribute__((ext_vector_type(8)));
typedef float f32x4 __attribute__((ext_vector_type(4)));
typedef float f32x16 __attribute__((ext_vector_type(16)));
typedef unsigned u32x4 __attribute__((ext_vector_type(4)));
#define GAS __attribute__((address_space(1)))
typedef GAS bf16_t gbf;
typedef GAS float gfl;
typedef GAS unsigned char gu8;
typedef GAS unsigned long long gu64;

__device__ __forceinline__ unsigned cvt_pk_bf16(float lo, float hi) { unsigned r; asm("v_cvt_pk_bf16_f32 %0, %1, %2" : "=v"(r) : "v"(lo), "v"(hi)); return r; }
__device__ __forceinline__ int opaque_v(int v) { asm volatile("" : "+v"(v)); return v; }
template <class T> __device__ __forceinline__ T* uni(T* p) {
    const unsigned long long v = (unsigned long long)p; const unsigned lo = __builtin_amdgcn_readfirstlane((unsigned)v), hi = __builtin_amdgcn_readfirstlane((unsigned)(v >> 32));
    return (T*)(((unsigned long long)hi << 32) | lo); }
__device__ __forceinline__ float unif(float v) { return __int_as_float(__builtin_amdgcn_readfirstlane(__float_as_int(v))); }
__device__ __forceinline__ float bf_lo(unsigned w) { return __uint_as_float(w << 16); }
__device__ __forceinline__ float bf_hi(unsigned w) { return __uint_as_float(w & 0xffff0000u); }
template <int M> __device__ __forceinline__ float swz_xor(float v) { return __int_as_float(__builtin_amdgcn_ds_swizzle(__float_as_int(v), 0x1f | (M << 10))); }
__device__ __forceinline__ float sum_x32(float v) { auto rr = __builtin_amdgcn_permlane32_swap(__float_as_uint(v), __float_as_uint(v), false, false); return __uint_as_float(rr[0]) + __uint_as_float(rr[1]); }
__device__ __forceinline__ float max_x32(float v) { auto rr = __builtin_amdgcn_permlane32_swap(__float_as_uint(v), __float_as_uint(v), false, false); return __builtin_fmaxf(__uint_as_float(rr[0]), __uint_as_float(rr[1])); }
__device__ __forceinline__ float sum_row32(float v) { v += swz_xor<1>(v); v += swz_xor<2>(v); v += swz_xor<4>(v); v += swz_xor<8>(v); v += swz_xor<16>(v); return v; }
__device__ __forceinline__ float wave_sum(float v) { return sum_x32(sum_row32(v)); }
__device__ __forceinline__ float nopack(float v) { asm("" : "+v"(v)); return v; }
__device__ __forceinline__ float max3f(float a, float b, float c) { float r; asm("v_max3_f32 %0, %1, %2, %3" : "=v"(r) : "v"(a), "v"(b), "v"(c)); return r; }
__device__ __forceinline__ float max2f(float a, float b) { float r; asm("v_max_f32_e32 %0, %1, %2" : "=v"(r) : "v"(a), "v"(b)); return r; }
template <int CTRL> __device__ __forceinline__ float dpp_self(float v) { return __int_as_float(__builtin_amdgcn_update_dpp(__float_as_int(v), __float_as_int(v), CTRL, 0xf, 0xf, false)); }
__device__ __forceinline__ float wave_max_uniform(float v) {
    v = max2f(v, dpp_self<0x121>(v)); v = max2f(v, dpp_self<0x122>(v)); v = max2f(v, dpp_self<0x124>(v)); v = max2f(v, dpp_self<0x128>(v));
    const float a = __int_as_float(__builtin_amdgcn_readlane(__float_as_int(v), 0)), b = __int_as_float(__builtin_amdgcn_readlane(__float_as_int(v), 16)),
                c = __int_as_float(__builtin_amdgcn_readlane(__float_as_int(v), 32)), d = __int_as_float(__builtin_amdgcn_readlane(__float_as_int(v), 48));
    return __builtin_fmaxf(__builtin_fmaxf(a, b), __builtin_fmaxf(c, d));
}
template <int CTRL> __device__ __forceinline__ float dpp_mov(float v) { return __int_as_float(__builtin_amdgcn_update_dpp(0, __float_as_int(v), CTRL, 0xf, 0xf, false)); }

constexpr int DM = 1024, MG = 65536;
constexpr int NPROJ = 3840;
constexpr int C_QA = 0, C_KA = 512, C_QB = 1024, C_GA = 1536, C_GB = 2560, C_KB = 3584;
constexpr int NVT = 768;
constexpr int DFF = 2816, NUP = 5632;
constexpr float QSCALE = 0.125f * 1.4426950408889634f;
constexpr float LOG2E = 1.4426950408889634f;
constexpr float EPS = 1e-6f;

constexpr size_t MiB = 1u << 20;
constexpr size_t WS_W = 0, W_LAYER = 32 * MiB;
constexpr size_t W_W1T = 0, W_WVT = 7864320, W_WPA = 9437184, W_WPB = 10485760, W_WOUT = 11534336, W_WUP = 13631488, W_WDOWN = 25165824;
constexpr size_t WS_HB = 64 * MiB, WS_PROJ = 192 * MiB, WS_VT = 672 * MiB, WS_Y = 768 * MiB, WS_G = 192 * MiB, WS_END = 896 * MiB;
constexpr size_t WS_Q = 31 * MiB + 640 * 1024;
constexpr size_t WS_KN2 = 31 * MiB + 512 * 1024;
constexpr size_t WS_SSA = 30 * MiB, WS_SSB = 30 * MiB + 512 * 1024;

namespace pg8 {
constexpr int BM = 256, BK = 64, HALF = 128, HTB = HALF * BK * 2, STAGE_BYTES = 8 * HTB, NXCD = 8, WGM = 8;
__host__ __device__ __forceinline__ int lds_byte(int r, int c) { const int st = (r >> 4) * 2 + (c >> 5), rr = r & 15, cc = c & 31, ob = rr * 64 + cc * 2; return st * 1024 + (ob ^ (((ob >> 9) & 1) << 5)); }
__host__ __device__ __forceinline__ void stage_rc(int b, int& R, int& C) { const int st = b / 1024, sb = b % 1024, swz = sb ^ (((sb >> 9) & 1) << 5); R = (st >> 1) * 16 + swz / 64; C = (st & 1) * 32 + (swz % 64) / 2; }
__host__ __device__ __forceinline__ int perm32(int rho) { const int n = rho >> 4, i = rho & 15; return 8 * (i >> 2) + 4 * n + (i & 3); }

struct Unit { int pm, pn; };
struct Gemm { const gbf* A; const gbf* Bt; int M, N, K, lda, ldb; };

struct StaticOrder {
    int nM, nN, nwg, G, c;
    __device__ void init(int M, int N, int G_, int c_) { nM = M / BM; nN = N / BM; nwg = nM * nN; G = G_; c = c_; }
    __device__ void init_tiles(int nM_, int nN_, int G_, int c_) { nM = nM_; nN = nN_; nwg = nM * nN; G = G_; c = c_; }
    __device__ bool next(int i, Unit& u) const {
        const long L = (long)i * G + c; if (L >= nwg) return false;
        int wgid = (int)L; { const int q = nwg / NXCD, r = nwg % NXCD, xcd = wgid % NXCD, off = wgid / NXCD; wgid = (xcd < r ? xcd * (q + 1) : r * (q + 1) + (xcd - r) * q) + off; }
        const int nig = WGM * nN, gid = wgid / nig, fm = gid * WGM, gsz = (nM - fm) < WGM ? (nM - fm) : WGM;
        u.pm = fm + ((wgid % nig) % gsz); u.pn = (wgid % nig) / gsz; return true;
    }
};

struct EpiStoreBf16 {
    static constexpr bool PERM = true;
    gbf* O; size_t ldc;
    __device__ __forceinline__ void operator()(const f32x4 (&acc)[2][2][4][2], const Unit& u, int wr, int wc, int fr, int fq) const {
        const int row0 = u.pm * BM + wr * 64 + fr, col0 = u.pn * BM + wc * 32 + 8 * fq;
#pragma unroll
        for (int ai = 0; ai < 2; ++ai)
#pragma unroll
            for (int m = 0; m < 4; ++m) { gbf* rowp = O + (size_t)(row0 + ai * HALF + m * 16) * ldc + col0;
#pragma unroll
                for (int bj = 0; bj < 2; ++bj) { const f32x4 v0 = acc[ai][bj][m][0], v1 = acc[ai][bj][m][1];
                    u32x4 w; w.x = cvt_pk_bf16(v0[0], v0[1]); w.y = cvt_pk_bf16(v0[2], v0[3]); w.z = cvt_pk_bf16(v1[0], v1[1]); w.w = cvt_pk_bf16(v1[2], v1[3]);
                    *(GAS u32x4*)(rowp + bj * HALF) = w; } }
    }
};
template <bool ACCUM> struct EpiGate {
    static constexpr bool PERM = true;
    gbf* O; int ldc; const gbf* G; int ldg; const gfl* bias;
    __device__ __forceinline__ void operator()(const f32x4 (&acc)[2][2][4][2], const Unit& u, int wr, int wc, int fr, int fq) const {
        const int row0 = u.pm * BM + wr * 64 + fr, col0 = u.pn * BM + wc * 32 + 8 * fq;
#pragma unroll
        for (int bj = 0; bj < 2; ++bj) {
            const f32x4 b0 = *(const GAS f32x4*)(bias + col0 + bj * HALF) * (-LOG2E), b1 = *(const GAS f32x4*)(bias + col0 + bj * HALF + 4) * (-LOG2E);
#pragma unroll
            for (int ai = 0; ai < 2; ++ai) {
                u32x4 gwv[4], owv[4];
#pragma unroll
                for (int m = 0; m < 4; ++m) { const size_t row = (size_t)(row0 + ai * HALF + m * 16);
                    gwv[m] = *(const GAS u32x4*)(G + row * ldg + col0 + bj * HALF);
                    if (ACCUM) owv[m] = *(const GAS u32x4*)(O + row * ldc + col0 + bj * HALF); }
#pragma unroll
                for (int m = 0; m < 4; ++m) { const size_t row = (size_t)(row0 + ai * HALF + m * 16);
                    const u32x4 gw = gwv[m];
                    gbf* op = O + row * ldc + col0 + bj * HALF;
                    float z[8] = {__builtin_fmaf(bf_lo(gw.x), -LOG2E, b0[0]), __builtin_fmaf(bf_hi(gw.x), -LOG2E, b0[1]), __builtin_fmaf(bf_lo(gw.y), -LOG2E, b0[2]), __builtin_fmaf(bf_hi(gw.y), -LOG2E, b0[3]), __builtin_fmaf(bf_lo(gw.z), -LOG2E, b1[0]), __builtin_fmaf(bf_hi(gw.z), -LOG2E, b1[1]), __builtin_fmaf(bf_lo(gw.w), -LOG2E, b1[2]), __builtin_fmaf(bf_hi(gw.w), -LOG2E, b1[3])};
                    const f32x4 v0 = acc[ai][bj][m][0], v1 = acc[ai][bj][m][1];
                    float a[8] = {v0[0], v0[1], v0[2], v0[3], v1[0], v1[1], v1[2], v1[3]};
                    float r[8];
#pragma unroll
                    for (int i = 0; i < 8; ++i) r[i] = a[i] * __builtin_amdgcn_rcpf(1.f + __builtin_amdgcn_exp2f(z[i]));
                    if (ACCUM) { const u32x4 ow = owv[m];
                        r[0] += bf_lo(ow.x); r[1] += bf_hi(ow.x); r[2] += bf_lo(ow.y); r[3] += bf_hi(ow.y); r[4] += bf_lo(ow.z); r[5] += bf_hi(ow.z); r[6] += bf_lo(ow.w); r[7] += bf_hi(ow.w); }
                    u32x4 w; w.x = cvt_pk_bf16(r[0], r[1]); w.y = cvt_pk_bf16(r[2], r[3]); w.z = cvt_pk_bf16(r[4], r[5]); w.w = cvt_pk_bf16(r[6], r[7]);
                    *(GAS u32x4*)op = w; }
            }
        }
    }
};
struct EpiResid {
    static constexpr bool PERM = false;
    const gfl* base; gfl* out; int ldc;
    __device__ __forceinline__ void operator()(const f32x4 (&acc)[2][2][4][2], const Unit& u, int wr, int wc, int fr, int fq) const {
        const int row0 = u.pm * BM + wr * 64 + fr, col0 = u.pn * BM + wc * 32 + 4 * fq;
#pragma unroll
        for (int ai = 0; ai < 2; ++ai)
#pragma unroll
            for (int m = 0; m < 4; ++m) { const size_t off = (size_t)(row0 + ai * HALF + m * 16) * ldc + col0;
#pragma unroll
                for (int bj = 0; bj < 2; ++bj)
#pragma unroll
                    for (int n = 0; n < 2; ++n) { const f32x4 bs = *(const GAS f32x4*)(base + off + bj * HALF + n * 16); *(GAS f32x4*)(out + off + bj * HALF + n * 16) = bs + acc[ai][bj][m][n]; } }
    }
};

__device__ __forceinline__ float rstd_of(unsigned long long ssq) { return __builtin_amdgcn_rsqf((float)ssq * (1.f / (1024.f * 1048576.f)) + EPS); }
struct EpiStoreRow {
    static constexpr bool PERM = true;
    gbf* O; size_t ldc; const gu64* ssq; GAS unsigned* kn2; int S;
    __device__ __forceinline__ void operator()(const f32x4 (&acc)[2][2][4][2], const Unit& u, int wr, int wc, int fr, int fq) const {
        const int row0 = u.pm * BM + wr * 64 + fr, col0 = u.pn * BM + wc * 32 + 8 * fq;
        const bool ktile = (u.pn == 2 || u.pn == 3);
        float mxsq[2] = {0.f, 0.f};
        float rsv[2][4];
        if (ssq) { unsigned long long q[2][4];
#pragma unroll
            for (int ai = 0; ai < 2; ++ai)
#pragma unroll
                for (int m = 0; m < 4; ++m) q[ai][m] = ssq[row0 + ai * HALF + m * 16];
#pragma unroll
            for (int ai = 0; ai < 2; ++ai)
#pragma unroll
                for (int m = 0; m < 4; ++m) rsv[ai][m] = rstd_of(q[ai][m]);
        } else {
#pragma unroll
            for (int ai = 0; ai < 2; ++ai)
#pragma unroll
                for (int m = 0; m < 4; ++m) rsv[ai][m] = 1.f; }
#pragma unroll
        for (int ai = 0; ai < 2; ++ai)
#pragma unroll
            for (int m = 0; m < 4; ++m) { const int row = row0 + ai * HALF + m * 16; gbf* rowp = O + (size_t)row * ldc + col0;
                const float rs = rsv[ai][m];
#pragma unroll
                for (int bj = 0; bj < 2; ++bj) { const f32x4 v0 = acc[ai][bj][m][0] * rs, v1 = acc[ai][bj][m][1] * rs;
                    u32x4 w; w.x = cvt_pk_bf16(v0[0], v0[1]); w.y = cvt_pk_bf16(v0[2], v0[3]); w.z = cvt_pk_bf16(v1[0], v1[1]); w.w = cvt_pk_bf16(v1[2], v1[3]);
                    *(GAS u32x4*)(rowp + bj * HALF) = w;
                    if (ktile) { float q = (v0[0] * v0[0] + v0[1] * v0[1]) + (v0[2] * v0[2] + v0[3] * v0[3]) + (v1[0] * v1[0] + v1[1] * v1[1]) + (v1[2] * v1[2] + v1[3] * v1[3]);
                        q += swz_xor<16>(q); q = sum_x32(q); mxsq[bj] = __builtin_fmaxf(mxsq[bj], q); } } }
        if (ktile) {
#pragma unroll
            for (int bj = 0; bj < 2; ++bj) { float q = mxsq[bj];
                q = __builtin_fmaxf(q, swz_xor<1>(q)); q = __builtin_fmaxf(q, swz_xor<2>(q)); q = __builtin_fmaxf(q, swz_xor<4>(q)); q = __builtin_fmaxf(q, swz_xor<8>(q));
                if (fr == 0 && fq == 0) { const int b = (u.pm * BM) / S, grp = (u.pn - 2) * 8 + bj * 4 + wc;
                    (void)__hip_atomic_fetch_max(kn2 + b * 16 + grp, __float_as_uint(q), __ATOMIC_RELAXED, __HIP_MEMORY_SCOPE_AGENT); } }
        }
    }
};
struct EpiStoreCol {
    static constexpr bool PERM = true;
    gbf* O; size_t ldc; const gu64* ssq;
    __device__ __forceinline__ void operator()(const f32x4 (&acc)[2][2][4][2], const Unit& u, int wr, int wc, int fr, int fq) const {
        const int row0 = u.pm * BM + wr * 64 + fr, col0 = u.pn * BM + wc * 32 + 8 * fq;
        f32x4 cs[2][2];
#pragma unroll
        for (int bj = 0; bj < 2; ++bj)
#pragma unroll
            for (int n = 0; n < 2; ++n) { if (ssq) { const gu64* q = ssq + col0 + bj * HALF + 4 * n; cs[bj][n] = (f32x4){rstd_of(q[0]), rstd_of(q[1]), rstd_of(q[2]), rstd_of(q[3])}; } else cs[bj][n] = (f32x4){1.f, 1.f, 1.f, 1.f}; }
#pragma unroll
        for (int ai = 0; ai < 2; ++ai)
#pragma unroll
            for (int m = 0; m < 4; ++m) { gbf* rowp = O + (size_t)(row0 + ai * HALF + m * 16) * ldc + col0;
#pragma unroll
                for (int bj = 0; bj < 2; ++bj) { const f32x4 v0 = acc[ai][bj][m][0] * cs[bj][0], v1 = acc[ai][bj][m][1] * cs[bj][1];
                    u32x4 w; w.x = cvt_pk_bf16(v0[0], v0[1]); w.y = cvt_pk_bf16(v0[2], v0[3]); w.z = cvt_pk_bf16(v1[0], v1[1]); w.w = cvt_pk_bf16(v1[2], v1[3]);
                    *(GAS u32x4*)(rowp + bj * HALF) = w; } }
    }
};
struct EpiResidNorm {
    static constexpr bool PERM = false;
    const gfl* base; gfl* out; int ldc; gbf* xb; const gfl* gn; gu64* ssq; bool do_norm;
    __device__ __forceinline__ void operator()(const f32x4 (&acc)[2][2][4][2], const Unit& u, int wr, int wc, int fr, int fq) const {
        typedef unsigned u32x2 __attribute__((ext_vector_type(2)));
        fr = opaque_v(fr); fq = opaque_v(fq);
        const int row0 = u.pm * BM + wr * 64 + fr, col0 = u.pn * BM + wc * 32 + 4 * fq;
        f32x4 gv[2][2];
#pragma unroll
        for (int bj = 0; bj < 2; ++bj)
#pragma unroll
            for (int n = 0; n < 2; ++n) gv[bj][n] = do_norm ? *(const GAS f32x4*)(gn + col0 + bj * HALF + n * 16) : (f32x4){0.f, 0.f, 0.f, 0.f};
#pragma unroll
        for (int ai = 0; ai < 2; ++ai)
#pragma unroll
            for (int mh = 0; mh < 2; ++mh) {
                f32x4 bsv[2][2][2];
#pragma unroll
                for (int mm = 0; mm < 2; ++mm) { const size_t off = (size_t)(row0 + ai * HALF + (2 * mh + mm) * 16) * ldc + col0;
#pragma unroll
                    for (int bj = 0; bj < 2; ++bj)
#pragma unroll
                        for (int n = 0; n < 2; ++n) bsv[mm][bj][n] = *(const GAS f32x4*)(base + off + bj * HALF + n * 16); }
#pragma unroll
                for (int mm = 0; mm < 2; ++mm) { const int m = 2 * mh + mm, row = row0 + ai * HALF + m * 16; const size_t off = (size_t)row * ldc + col0; float sq = 0.f;
#pragma unroll
                    for (int bj = 0; bj < 2; ++bj)
#pragma unroll
                        for (int n = 0; n < 2; ++n) { const f32x4 v = bsv[mm][bj][n] + acc[ai][bj][m][n]; *(GAS f32x4*)(out + off + bj * HALF + n * 16) = v;
                            if (do_norm) { sq += (v[0] * v[0] + v[1] * v[1]) + (v[2] * v[2] + v[3] * v[3]); const f32x4 w = v * gv[bj][n];
                                u32x2 pk; pk.x = cvt_pk_bf16(w[0], w[1]); pk.y = cvt_pk_bf16(w[2], w[3]); *(GAS u32x2*)(xb + off + bj * HALF + n * 16) = pk; } }
                    if (do_norm) { sq += swz_xor<16>(sq); sq = sum_x32(sq); if (fq == 0) (void)__hip_atomic_fetch_add(ssq + row, (unsigned long long)(sq * 1048576.f + 0.5f), __ATOMIC_RELAXED, __HIP_MEMORY_SCOPE_AGENT); } }
            }
    }
};
struct EpiConv {
    static constexpr bool PERM = true;
    gbf* Gout; const gu64* ssq; const gfl* cw; const gfl* cb; LAS float* xch; int S, M;
    __device__ __forceinline__ void operator()(const f32x4 (&acc)[2][2][4][2], const Unit& u, int wr, int wc, int fr, int fq) const {
        fr = opaque_v(fr); fq = opaque_v(fq);
        const int out_lo = u.pm * 254; int base = out_lo - 1; base = base < 0 ? 0 : base; base = base > M - 256 ? M - 256 : base;
        const int out_hi = out_lo + 254 < M ? out_lo + 254 : M;
        const int colh = wc * 32 + 8 * fq, f0 = u.pn * 128 + colh;
        float w0[8], w1[8], w2[8], bb[8];
        { const f32x4 a0 = *(const GAS f32x4*)(cw + f0), a1 = *(const GAS f32x4*)(cw + f0 + 4), b0 = *(const GAS f32x4*)(cw + DFF + f0), b1 = *(const GAS f32x4*)(cw + DFF + f0 + 4),
                      c0 = *(const GAS f32x4*)(cw + 2 * DFF + f0), c1 = *(const GAS f32x4*)(cw + 2 * DFF + f0 + 4), d0 = *(const GAS f32x4*)(cb + f0), d1 = *(const GAS f32x4*)(cb + f0 + 4);
#pragma unroll
          for (int k = 0; k < 4; ++k) { w0[k] = a0[k]; w0[4 + k] = a1[k]; w1[k] = b0[k]; w1[4 + k] = b1[k]; w2[k] = c0[k]; w2[4 + k] = c1[k]; bb[k] = d0[k]; bb[4 + k] = d1[k]; } }
        float rs[2][4];
#pragma unroll
        for (int ai = 0; ai < 2; ++ai)
#pragma unroll
            for (int m = 0; m < 4; ++m) rs[ai][m] = __builtin_bit_cast(float, 0);
        { unsigned long long q[2][4];
#pragma unroll
          for (int ai = 0; ai < 2; ++ai)
#pragma unroll
              for (int m = 0; m < 4; ++m) q[ai][m] = ssq[base + ai * HALF + wr * 64 + m * 16 + fr];
#pragma unroll
          for (int ai = 0; ai < 2; ++ai)
#pragma unroll
              for (int m = 0; m < 4; ++m) rs[ai][m] = rstd_of(q[ai][m]); }
#pragma unroll
        for (int ai = 0; ai < 2; ++ai) {
            const bool isf = fr == 0; LAS float* d = xch + ((ai * 2 + wr) * 2 + (isf ? 0 : 1)) * 128 + colh;
#pragma unroll
            for (int k = 0; k < 8; ++k) { const float vf = acc[ai][0][0][k >> 2][k & 3] * rs[ai][0], vl = acc[ai][0][3][k >> 2][k & 3] * rs[ai][3];
                float v; asm("v_cndmask_b32 %0, %1, %2, %3" : "=v"(v) : "v"(vl), "v"(vf), "s"(__builtin_amdgcn_ballot_w64(isf)));
                if (fr == 0 || fr == 15) d[k] = v; }
        }
        asm volatile("s_waitcnt lgkmcnt(0)" ::: "memory"); __builtin_amdgcn_s_barrier(); asm volatile("" ::: "memory");
#pragma unroll
        for (int ai = 0; ai < 2; ++ai)
#pragma unroll
            for (int m = 0; m < 4; ++m) {
                const int chunk = ai * 2 + wr, row = base + ai * HALF + wr * 64 + m * 16 + fr, pos = row & (S - 1);
                float gsv[8];
#pragma unroll
                for (int k = 0; k < 8; ++k) {
                    const float am = acc[ai][0][m][k >> 2][k & 3] * rs[ai][m];
                    float sp, sn;
                    if (m > 0) sp = fr == 15 ? acc[ai][0][m - 1][k >> 2][k & 3] * rs[ai][m - 1] : am; else sp = am;
                    if (m < 3) sn = fr == 0 ? acc[ai][0][m + 1][k >> 2][k & 3] * rs[ai][m + 1] : am; else sn = am;
                    float pv = dpp_mov<0x121>(sp), nv = dpp_mov<0x12F>(sn);
                    if (m == 0) { const float e = chunk > 0 ? xch[((chunk - 1) * 2 + 1) * 128 + colh + k] : 0.f; pv = fr == 0 ? e : pv; }
                    if (m == 3) { const float e = chunk < 3 ? xch[((chunk + 1) * 2 + 0) * 128 + colh + k] : 0.f; nv = fr == 15 ? e : nv; }
                    pv = pos == 0 ? 0.f : pv; nv = pos == S - 1 ? 0.f : nv;
                    const float c = pv * w0[k] + am * w1[k] + nv * w2[k] + bb[k];
                    const float ge = c * __builtin_amdgcn_rcpf(1.f + __builtin_amdgcn_exp2f(c * __builtin_fmaf(-0.10294324f, c * c, -2.3022082f)));
                    gsv[k] = ge * (acc[ai][1][m][k >> 2][k & 3] * rs[ai][m]);
                }
                if (row >= out_lo && row < out_hi) {
                    u32x4 w; w.x = cvt_pk_bf16(gsv[0], gsv[1]); w.y = cvt_pk_bf16(gsv[2], gsv[3]); w.z = cvt_pk_bf16(gsv[4], gsv[5]); w.w = cvt_pk_bf16(gsv[6], gsv[7]);
                    *(GAS u32x4*)(Gout + (size_t)row * DFF + f0) = w; }
            }
    }
};

template <class Epi, class Sched, bool ALIGN_EPI, int ASTEP = 256>
__device__ __forceinline__ void gemm_phase(LAS unsigned char* lds, const Gemm g, const Sched& S, const Epi& E, const int tid) {
    const int wid = __builtin_amdgcn_readfirstlane(tid >> 6), lane = tid & 63, wr = wid >> 2, wc = wid & 3, fr = lane & 15, fq = lane >> 4;
    const int K = g.K, nt = K / BK;
    unsigned voffA[2], voffB[2];
#pragma unroll
    for (int i = 0; i < 2; ++i) { int R, C; stage_rc(tid * 16 + i * 8192, R, C); const int Rb = Epi::PERM ? ((R & ~31) + perm32(R & 31)) : R;
        voffA[i] = (unsigned)(R * g.lda + C) * 2u; voffB[i] = (unsigned)(Rb * g.ldb + C) * 2u; }
    const size_t kstep = (size_t)(BK * 2);
    const size_t hstepA = (size_t)HALF * g.lda * 2, hstepB = (size_t)HALF * g.ldb * 2;
    const size_t tstepB = 2 * hstepB;
#define PG8_ABASE(pm) ((const GAS char*)g.A + (size_t)(ASTEP == 256 ? (pm) * 256 : (((pm) * ASTEP - 1) < 0 ? 0 : (((pm) * ASTEP - 1) > g.M - 256 ? g.M - 256 : ((pm) * ASTEP - 1)))) * g.lda * 2)
    const unsigned ldsw = (unsigned)wid * 1024u;
    const int aoff = lds_byte(wr * 64 + fr, fq * 8), boff = lds_byte(wc * 32 + fr, fq * 8);
#define PG8_SA(b, h) (((b) * 2 + (h)) * HTB)
#define PG8_SB(b, h) ((4 + (b) * 2 + (h)) * HTB)
#define PG8_STAGE(bufoff, gbase, voff) do { _Pragma("unroll") for (int _i = 0; _i < 2; ++_i) \
        __builtin_amdgcn_global_load_lds((const GAS unsigned*)((const GAS char*)(gbase) + (voff)[_i]), (LAS unsigned*)(lds + (bufoff) + ldsw + _i * 8192), 16, 0, 0); } while (0)
#define PG8_LDA(dst, b, h) do { _Pragma("unroll") for (int m = 0; m < 4; ++m) _Pragma("unroll") for (int k = 0; k < 2; ++k) dst[m][k] = *(const LAS bf16x8*)(lds + PG8_SA(b, h) + aoff + m * 2048 + k * 1024); } while (0)
#define PG8_LDB(dst, b, h) do { _Pragma("unroll") for (int n = 0; n < 2; ++n) _Pragma("unroll") for (int k = 0; k < 2; ++k) dst[n][k] = *(const LAS bf16x8*)(lds + PG8_SB(b, h) + boff + n * 2048 + k * 1024); } while (0)
#define PG8_MMA(ai, bj, At, Bt) do { __builtin_amdgcn_s_setprio(1); _Pragma("unroll") for (int m = 0; m < 4; ++m) _Pragma("unroll") for (int n = 0; n < 2; ++n) _Pragma("unroll") for (int k = 0; k < 2; ++k) \
        acc[ai][bj][m][n] = __builtin_amdgcn_mfma_f32_16x16x32_bf16(Bt[n][k], At[m][k], acc[ai][bj][m][n], 0, 0, 0); __builtin_amdgcn_s_setprio(0); } while (0)
#define PG8_WAIT_V(n) asm volatile("s_waitcnt vmcnt(" #n ")" ::: "memory")
#define PG8_WAIT_L(n) asm volatile("s_waitcnt lgkmcnt(" #n ")" ::: "memory")
#define PG8_BAR __builtin_amdgcn_s_barrier()
#define PG8_SCHED __builtin_amdgcn_sched_barrier(0)
    Unit cur, nxt; int ui = 0;
    if (!S.next(0, cur)) return;
    f32x4 acc[2][2][4][2];
#pragma unroll
    for (int a = 0; a < 2; ++a)
#pragma unroll
        for (int b = 0; b < 2; ++b)
#pragma unroll
            for (int m = 0; m < 4; ++m)
#pragma unroll
                for (int n = 0; n < 2; ++n) acc[a][b][m][n] = (f32x4){0.f, 0.f, 0.f, 0.f};
    bf16x8 At[4][2], B0[2][2], B1[2][2];
    const GAS char* cA = PG8_ABASE(cur.pm); const GAS char* cB = (const GAS char*)g.Bt + (size_t)cur.pn * tstepB;
    PG8_STAGE(PG8_SB(0, 0), cB, voffB); PG8_STAGE(PG8_SB(0, 1), cB + hstepB, voffB); PG8_STAGE(PG8_SA(0, 0), cA, voffA); PG8_STAGE(PG8_SA(0, 1), cA + hstepA, voffA);
    if (wr == 1) PG8_BAR;
    PG8_WAIT_V(2); PG8_BAR;
    PG8_STAGE(PG8_SB(1, 0), cB + kstep, voffB); PG8_STAGE(PG8_SA(1, 0), cA + kstep, voffA); PG8_STAGE(PG8_SB(1, 1), cB + hstepB + kstep, voffB);
    PG8_WAIT_V(6); PG8_BAR;
    for (;;) {
        const bool has_next = S.next(ui + 1, nxt);
        const GAS char* nA = has_next ? PG8_ABASE(nxt.pm) : cA; const GAS char* nB = has_next ? (const GAS char*)g.Bt + (size_t)nxt.pn * tstepB : cB;
        for (int t = 0; t < nt; t += 2) {
            const bool last = (t == nt - 2);
            const GAS char* a1 = cA + (size_t)(t + 1) * kstep;
            const GAS char* a2 = last ? nA : cA + (size_t)(t + 2) * kstep; const GAS char* b2 = last ? nB : cB + (size_t)(t + 2) * kstep;
            const GAS char* a3 = a2 + kstep; const GAS char* b3 = b2 + kstep;
            PG8_LDB(B0, 0, 0); PG8_LDB(B1, 0, 1); PG8_SCHED; PG8_LDA(At, 0, 0); PG8_STAGE(PG8_SA(1, 1), a1 + hstepA, voffA);
            PG8_WAIT_V(8); PG8_WAIT_L(0); PG8_BAR; PG8_MMA(0, 0, At, B0); PG8_MMA(0, 1, At, B1); PG8_BAR; PG8_SCHED;
            PG8_LDA(At, 0, 1); PG8_STAGE(PG8_SB(0, 0), b2, voffB); PG8_STAGE(PG8_SB(0, 1), b2 + hstepB, voffB); PG8_STAGE(PG8_SA(0, 0), a2, voffA);
            PG8_WAIT_V(8); PG8_WAIT_L(0); PG8_BAR; PG8_MMA(1, 0, At, B0); PG8_MMA(1, 1, At, B1); PG8_BAR; PG8_SCHED;
            PG8_LDB(B0, 1, 0); PG8_LDB(B1, 1, 1); PG8_SCHED; PG8_LDA(At, 1, 0); PG8_STAGE(PG8_SA(0, 1), a2 + hstepA, voffA);
            PG8_WAIT_V(8); PG8_WAIT_L(0); PG8_BAR; PG8_MMA(0, 0, At, B0); PG8_MMA(0, 1, At, B1); PG8_BAR; PG8_SCHED;
            PG8_LDA(At, 1, 1); PG8_STAGE(PG8_SB(1, 0), b3, voffB); PG8_STAGE(PG8_SB(1, 1), b3 + hstepB, voffB); PG8_STAGE(PG8_SA(1, 0), a3, voffA);
            PG8_WAIT_V(8); PG8_WAIT_L(0); PG8_BAR; PG8_MMA(1, 0, At, B0); PG8_MMA(1, 1, At, B1); PG8_BAR; PG8_SCHED;
        }
        if constexpr (ALIGN_EPI) { if (wr == 0) PG8_BAR; }
        E(acc, cur, wr, wc, fr, fq);
        if (!has_next) break;
#pragma unroll
        for (int a = 0; a < 2; ++a)
#pragma unroll
            for (int b = 0; b < 2; ++b)
#pragma unroll
                for (int m = 0; m < 4; ++m)
#pragma unroll
                    for (int n = 0; n < 2; ++n) acc[a][b][m][n] = (f32x4){0.f, 0.f, 0.f, 0.f};
        cur = nxt; cA = nA; cB = nB; ++ui;
        if constexpr (ALIGN_EPI) { if (wr == 1) PG8_BAR; }
    }
    PG8_WAIT_V(0);
    if constexpr (!ALIGN_EPI) { if (wr == 0) PG8_BAR; }
    PG8_BAR;
#undef PG8_ABASE
#undef PG8_SA
#undef PG8_SB
#undef PG8_STAGE
#undef PG8_LDA
#undef PG8_LDB
#undef PG8_MMA
#undef PG8_WAIT_V
#undef PG8_WAIT_L
#undef PG8_BAR
#undef PG8_SCHED
}
}

namespace att {
__device__ __forceinline__ int swap23(int r) { return (r & ~12) | ((r & 4) << 1) | ((r & 8) >> 1); }
__device__ __forceinline__ int crow(int r, int hi) { return (r & 3) + 8 * (r >> 2) + 4 * hi; }

template <int NDV, bool MASK, int KPITCH, int VPITCH>
__device__ __forceinline__ void wave_tile(const LAS char* kp, const LAS char* vp, const bf16x8 (&qf)[4], f32x16 (&o)[NDV], float& mref, float& lsum,
                                          const float dbase, const float nslope, LAS float* wsf, const int r32, const int hi) {
    f32x16 s0, s1;
#pragma unroll
    for (int r = 0; r < 16; ++r) { s0[r] = 0.f; s1[r] = 0.f; }
#pragma unroll
    for (int dc = 0; dc < 4; ++dc) {
        const bf16x8 a0 = *(const LAS bf16x8*)(kp + dc * 32);
        const bf16x8 a1 = *(const LAS bf16x8*)(kp + 32 * KPITCH + dc * 32);
        s0 = __builtin_amdgcn_mfma_f32_32x32x16_bf16(a0, qf[dc], s0, 0, 0, 0);
        s1 = __builtin_amdgcn_mfma_f32_32x32x16_bf16(a1, qf[dc], s1, 0, 0, 0);
    }
    float mx = -3.0e38f;
#pragma unroll
    for (int r = 0; r < 16; ++r) {
        const float c = (float)((r & 7) + 16 * (r >> 3));
        const float d0 = __builtin_fabsf(dbase + c), d1 = __builtin_fabsf(dbase + (c + 32.f));
        float t0 = __builtin_fmaf(nslope, d0, s0[r]), t1 = __builtin_fmaf(nslope, d1, s1[r]);
        if (MASK) { t0 = d0 <= 128.f ? t0 : -1e30f; t1 = d1 <= 128.f ? t1 : -1e30f; }
        s0[r] = t0; s1[r] = t1; mx = __builtin_fmaxf(mx, __builtin_fmaxf(t0, t1));
    }
    mx = max_x32(mx);
    if (__any(mx > mref + 8.f)) {
        const float mnew = __builtin_fmaxf(mref, mx); const float alpha = __builtin_amdgcn_exp2f(mref - mnew);
        lsum *= alpha; mref = mnew;
        if (hi == 0) wsf[r32] = alpha;
#pragma unroll
        for (int r = 0; r < 16; ++r) { const float al = wsf[crow(r, hi)];
#pragma unroll
            for (int d = 0; d < NDV; ++d) o[d][r] *= al; }
    }
    float rs = 0.f;
#pragma unroll
    for (int r = 0; r < 16; ++r) { s0[r] = __builtin_amdgcn_exp2f(s0[r] - mref); s1[r] = __builtin_amdgcn_exp2f(s1[r] - mref); rs += s0[r] + s1[r]; }
    lsum += rs;
    bf16x8 pa[4];
    { u32x4 w;
      w.x = cvt_pk_bf16(s0[0], s0[1]); w.y = cvt_pk_bf16(s0[2], s0[3]); w.z = cvt_pk_bf16(s0[4], s0[5]); w.w = cvt_pk_bf16(s0[6], s0[7]); pa[0] = __builtin_bit_cast(bf16x8, w);
      w.x = cvt_pk_bf16(s0[8], s0[9]); w.y = cvt_pk_bf16(s0[10], s0[11]); w.z = cvt_pk_bf16(s0[12], s0[13]); w.w = cvt_pk_bf16(s0[14], s0[15]); pa[1] = __builtin_bit_cast(bf16x8, w);
      w.x = cvt_pk_bf16(s1[0], s1[1]); w.y = cvt_pk_bf16(s1[2], s1[3]); w.z = cvt_pk_bf16(s1[4], s1[5]); w.w = cvt_pk_bf16(s1[6], s1[7]); pa[2] = __builtin_bit_cast(bf16x8, w);
      w.x = cvt_pk_bf16(s1[8], s1[9]); w.y = cvt_pk_bf16(s1[10], s1[11]); w.z = cvt_pk_bf16(s1[12], s1[13]); w.w = cvt_pk_bf16(s1[14], s1[15]); pa[3] = __builtin_bit_cast(bf16x8, w); }
#pragma unroll
    for (int d = 0; d < NDV; ++d)
#pragma unroll
        for (int c = 0; c < 4; ++c) {
            const bf16x8 vf = *(const LAS bf16x8*)(vp + d * 32 * VPITCH + c * 32);
            o[d] = __builtin_amdgcn_mfma_f32_32x32x16_bf16(pa[c], vf, o[d], 0, 0, 0);
        }
}

constexpr int A_KP = 272, A_VP = 144, A_KBYTES = 64 * A_KP, A_VBYTES = 128 * A_VP, A_BUF = A_KBYTES + A_VBYTES;
constexpr int B_KP = 144, B_VP = 144, B_KBYTES = 64 * B_KP, B_VBYTES = 64 * B_VP, B_BUF = B_KBYTES + B_VBYTES;
constexpr int WSF_OFF = 2 * A_BUF;
constexpr int ATT_LDS = WSF_OFF + 8 * 256;

template <int TYPE>
__device__ __forceinline__ void wave_tileA(const LAS char* lds, const int (&kad)[4], const int (&vad)[4], const bf16x8 (&qf)[4], f32x16 (&o)[4], float& mref, float& lsum,
                                           const float dbase, const float nslope, LAS float* wsf, const int r32, const int hi, const bool first, const bool chk) {
    f32x16 s0, s1;
    if (TYPE == 2) {
#pragma unroll
        for (int r = 0; r < 16; ++r) { const float c = (float)((r & 7) + 16 * (r >> 3));
            s0[r] = __builtin_fmaf(nslope, __builtin_fabsf(dbase + c), -mref); s1[r] = __builtin_fmaf(nslope, __builtin_fabsf(dbase + (c + 32.f)), -mref); }
    } else {
        const float sg = nslope, bl = __builtin_fmaf(sg, dbase, -mref);
#pragma unroll
        for (int r = 0; r < 16; ++r) { const float c = (float)((r & 7) + 16 * (r >> 3)); s0[r] = nopack(__builtin_fmaf(sg, c, bl)); s1[r] = nopack(__builtin_fmaf(sg, c + 32.f, bl)); }
    }
#pragma unroll
    for (int dc = 0; dc < 4; ++dc) {
        const bf16x8 a0 = *(const LAS bf16x8*)(lds + kad[dc]);
        const bf16x8 a1 = *(const LAS bf16x8*)(lds + kad[dc] + 8192);
        s0 = __builtin_amdgcn_mfma_f32_32x32x16_bf16(a0, qf[dc], s0, 0, 0, 0);
        s1 = __builtin_amdgcn_mfma_f32_32x32x16_bf16(a1, qf[dc], s1, 0, 0, 0);
    }
    if (chk) {
    asm volatile("s_nop 15\n\ts_nop 7" : "+v"(s0), "+v"(s1));
    float mx = max3f(s0[0], s1[0], s0[1]), mx2 = max3f(s1[1], s0[2], s1[2]);
#pragma unroll
    for (int r = 3; r < 15; r += 2) { mx = max3f(mx, s0[r], s1[r]); mx2 = max3f(mx2, s0[r + 1], s1[r + 1]); }
    mx = max3f(mx, s0[15], s1[15]); mx = max2f(mx, mx2);
    mx = max_x32(mx);
    if (first || __any(mx > 8.f)) {
        const float dl = first ? mx : __builtin_fmaxf(mx, 0.f), alpha = __builtin_amdgcn_exp2f(-dl);
        lsum *= alpha; mref += dl;
#pragma unroll
        for (int r = 0; r < 16; ++r) { s0[r] -= dl; s1[r] -= dl; }
        if (hi == 0) wsf[r32] = alpha;
#pragma unroll
        for (int r = 0; r < 16; ++r) { const float al = wsf[crow(r, hi)];
#pragma unroll
            for (int d = 0; d < 4; ++d) o[d][r] *= al; }
    }
    }
    float rsa = 0.f, rsb = 0.f;
#pragma unroll
    for (int r = 0; r < 16; ++r) { s0[r] = nopack(__builtin_amdgcn_exp2f(s0[r])); s1[r] = nopack(__builtin_amdgcn_exp2f(s1[r])); rsa = nopack(rsa + s0[r]); rsb = nopack(rsb + s1[r]); }
    lsum += rsa + rsb;
    bf16x8 pa[4];
    { u32x4 w;
      w.x = cvt_pk_bf16(s0[0], s0[1]); w.y = cvt_pk_bf16(s0[2], s0[3]); w.z = cvt_pk_bf16(s0[4], s0[5]); w.w = cvt_pk_bf16(s0[6], s0[7]); pa[0] = __builtin_bit_cast(bf16x8, w);
      w.x = cvt_pk_bf16(s0[8], s0[9]); w.y = cvt_pk_bf16(s0[10], s0[11]); w.z = cvt_pk_bf16(s0[12], s0[13]); w.w = cvt_pk_bf16(s0[14], s0[15]); pa[1] = __builtin_bit_cast(bf16x8, w);
      w.x = cvt_pk_bf16(s1[0], s1[1]); w.y = cvt_pk_bf16(s1[2], s1[3]); w.z = cvt_pk_bf16(s1[4], s1[5]); w.w = cvt_pk_bf16(s1[6], s1[7]); pa[2] = __builtin_bit_cast(bf16x8, w);
      w.x = cvt_pk_bf16(s1[8], s1[9]); w.y = cvt_pk_bf16(s1[10], s1[11]); w.z = cvt_pk_bf16(s1[12], s1[13]); w.w = cvt_pk_bf16(s1[14], s1[15]); pa[3] = __builtin_bit_cast(bf16x8, w); }
#pragma unroll
    for (int d = 0; d < 4; ++d)
#pragma unroll
        for (int c = 0; c < 4; ++c) {
            const bf16x8 vf = *(const LAS bf16x8*)(lds + vad[c] + d * 4096);
            o[d] = __builtin_amdgcn_mfma_f32_32x32x16_bf16(pa[c], vf, o[d], 0, 0, 0);
        }
}

constexpr int A_STAGE = 32768, A_NSTAGE = 4, A_VOFF = 16384;
constexpr int WSFA_OFF = A_STAGE * A_NSTAGE;
constexpr int LIM_OFF = WSFA_OFF + 8 * 256;
constexpr int ATT_LDS2 = LIM_OFF + 128;
constexpr float SKIP_MARGIN = 136.f;

__device__ __forceinline__ void unitA(LAS char* lds, const gbf* PROJ, const gbf* VT, gbf* Y, const int S, const int tok0, const int h, const int qblk,
                                      const float lam, const float oml, const gfl* subln, const float kn2a, const float kn2b, const int tid_) {
    const int tid = opaque_v(tid_);
    const int lane = tid & 63, r32 = lane & 31, hi = lane >> 5, wid = __builtin_amdgcn_readfirstlane(tid >> 6), rg = wid >> 1, map = wid & 1;
    const int NT = S >> 6, tstart = qblk * 2;
    const int q0 = qblk * 128 + rg * 32;
    const float slope2 = LOG2E * __builtin_amdgcn_exp2f(-2.f * (float)(h + 1)), nslope = -slope2, inv_slope2 = 1.f / slope2;
    const bool skip_en = slope2 * (float)S > SKIP_MARGIN + 8.f;
    LAS float* wsf = (LAS float*)(lds + WSFA_OFF) + wid * 64;
    LAS float* lim = (LAS float*)(lds + LIM_OFF);
    asm volatile("s_waitcnt vmcnt(0)" ::: "memory");
    const gbf* ksrc[2]; const gbf* vsrc[2];
#pragma unroll
    for (int i = 0; i < 2; ++i) { const int j = 2 * wid + i;
        { const int row = 4 * j + (lane >> 4), c = (lane & 15) ^ (row & 15); ksrc[i] = PROJ + (size_t)(tok0 + row) * NPROJ + C_KA + h * 128 + c * 8; }
        { const int row = 8 * j + (lane >> 3), c = (lane & 7) ^ ((row >> 1) & 7); vsrc[i] = VT + (size_t)(h * 128 + row) * MG + tok0 + c * 8; } }
#define A_ISSUE(tile, stage) do { const int kv0_ = (tile) * 64; LAS char* sb_ = lds + (stage) * A_STAGE + wid * 2048; \
        __builtin_amdgcn_global_load_lds((const GAS unsigned*)(ksrc[0] + (size_t)kv0_ * NPROJ), (LAS unsigned*)(sb_), 16, 0, 0); \
        __builtin_amdgcn_global_load_lds((const GAS unsigned*)(ksrc[1] + (size_t)kv0_ * NPROJ), (LAS unsigned*)(sb_ + 1024), 16, 0, 0); \
        __builtin_amdgcn_global_load_lds((const GAS unsigned*)(vsrc[0] + kv0_), (LAS unsigned*)(sb_ + A_VOFF), 16, 0, 0); \
        __builtin_amdgcn_global_load_lds((const GAS unsigned*)(vsrc[1] + kv0_), (LAS unsigned*)(sb_ + A_VOFF + 1024), 16, 0, 0); } while (0)
    bf16x8 qf[4];
    { const gbf* qp = PROJ + (size_t)(tok0 + q0 + r32) * NPROJ + C_QA + h * 128 + map * 64 + hi * 8;
#pragma unroll
      for (int dc = 0; dc < 4; ++dc) qf[dc] = *(const GAS bf16x8*)(qp + dc * 16); }
    float blkR = 3.0e38f, blkL = -3.0e38f;
    float ew = 3.0e38f;
    const int NT2 = NT >> 1, tstart2 = qblk;
    int dir = 1, tlast = tstart2;
#define A_GEN(dst) do { int tn_; \
        if (dir > 0) { tn_ = tlast + 1; if (tn_ >= NT2 || (float)(tn_ * 128) > blkR) { dir = -1; tn_ = tstart2 - 1; if (tn_ < 0 || (float)(tn_ * 128 + 127) < blkL) tn_ = -1; } } \
        else { tn_ = tlast - 1; if (tn_ < 0 || (float)(tn_ * 128 + 127) < blkL) tn_ = -1; } \
        if (tn_ >= 0) tlast = tn_; dst = tn_; } while (0)
    int tA = tstart2, tB;
    A_ISSUE(2 * tA, 0); A_ISSUE(2 * tA + 1, 1);
    float ub;
    { float qn = 0.f;
#pragma unroll
      for (int dc = 0; dc < 4; ++dc) { const u32x4 w = __builtin_bit_cast(u32x4, qf[dc]);
          qn += bf_lo(w.x) * bf_lo(w.x) + bf_hi(w.x) * bf_hi(w.x) + bf_lo(w.y) * bf_lo(w.y) + bf_hi(w.y) * bf_hi(w.y) + bf_lo(w.z) * bf_lo(w.z) + bf_hi(w.z) * bf_hi(w.z) + bf_lo(w.w) * bf_lo(w.w) + bf_hi(w.w) * bf_hi(w.w); }
      qn = sum_x32(qn);
      ub = __builtin_sqrtf(qn * ((map ? kn2b : kn2a) * 1.03f)) * 1.002f + 0.05f; }
    f32x16 o[4];
#pragma unroll
    for (int d = 0; d < 4; ++d)
#pragma unroll
        for (int r = 0; r < 16; ++r) o[d][r] = 0.f;
    float mref = 0.f, lsum = 0.f;
    int kbase[4], vbase[4];
    { const int krow = swap23(r32), km = krow & 15, vm = (r32 >> 1) & 7;
#pragma unroll
      for (int dc = 0; dc < 4; ++dc) kbase[dc] = krow * 256 + (((map * 8 + dc * 2 + hi) ^ km) << 4);
#pragma unroll
      for (int c = 0; c < 4; ++c) vbase[c] = A_VOFF + r32 * 128 + (((2 * c + hi) ^ vm) << 4); }
    const float qposf = (float)(q0 + r32 - 8 * hi);
    for (int it = 0;; ++it) {
        asm volatile("s_waitcnt vmcnt(0) lgkmcnt(0)\n\ts_barrier" ::: "memory");
        if (skip_en && it > 0) { const LAS f32x4* lp = (const LAS f32x4*)(lim + ((it - 1) & 1) * 16); const f32x4 a = lp[0], b = lp[1], c = lp[2], d = lp[3];
            blkR = __builtin_fmaxf(__builtin_fmaxf(__builtin_fmaxf(a[0], a[2]), __builtin_fmaxf(b[0], b[2])), __builtin_fmaxf(__builtin_fmaxf(c[0], c[2]), __builtin_fmaxf(d[0], d[2])));
            blkL = __builtin_fminf(__builtin_fminf(__builtin_fminf(a[1], a[3]), __builtin_fminf(b[1], b[3])), __builtin_fminf(__builtin_fminf(c[1], c[3]), __builtin_fminf(d[1], d[3])));
            blkR = unif(blkR); blkL = unif(blkL); }
        A_GEN(tB); if (tB >= 0) { A_ISSUE(2 * tB, 2 * ((it + 1) & 1)); A_ISSUE(2 * tB + 1, 2 * ((it + 1) & 1) + 1); }
#pragma unroll
        for (int sub = 0; sub < 2; ++sub) {
          const int kv0 = tA * 128 + sub * 64, sb = (2 * (it & 1) + sub) * A_STAGE; const float dbase = (float)kv0 - qposf;
          int kad[4], vad[4];
#pragma unroll
          for (int k = 0; k < 4; ++k) { kad[k] = kbase[k] + sb; vad[k] = vbase[k] + sb; }
          const int dmin = kv0 > q0 ? kv0 - (q0 + 31) : q0 - (kv0 + 63);
          const bool frst = it == 0 && sub == 0;
          const bool chk = frst || !(ew - slope2 * (float)dmin < 7.5f);
          if (kv0 + 63 < q0 || kv0 > q0 + 31) wave_tileA<0>(lds, kad, vad, qf, o, mref, lsum, dbase, kv0 > q0 ? nslope : -nslope, wsf, r32, hi, frst, chk);
          else wave_tileA<2>(lds, kad, vad, qf, o, mref, lsum, dbase, nslope, wsf, r32, hi, frst, true); }
        if (skip_en || (it & 1) == 0) ew = wave_max_uniform(ub - mref);
        if (skip_en) {
            const float e = ew;
            const float R = (e + SKIP_MARGIN) * inv_slope2;
            if (lane == 0) { lim[(it & 1) * 16 + wid * 2] = (float)(q0 + 31) + R; lim[(it & 1) * 16 + wid * 2 + 1] = (float)q0 - R; }
        }
        if (tB < 0) break;
        tA = tB;
    }
#undef A_ISSUE
#undef A_GEN
    asm volatile("s_waitcnt lgkmcnt(0)\n\ts_barrier" ::: "memory");
    float inv = 1.f / sum_x32(lsum);
    if (map == 1) inv *= lam;
    if (hi == 0) wsf[r32] = inv;
    float invr[16];
#pragma unroll
    for (int r = 0; r < 16; ++r) invr[r] = wsf[crow(r, hi)];
    LAS float* X = (LAS float*)lds + rg * 4096;
    if (map == 1) {
#pragma unroll
        for (int d = 0; d < 4; ++d)
#pragma unroll
            for (int r = 0; r < 16; ++r) X[(d * 16 + r) * 64 + lane] = o[d][r] * invr[r];
    }
    __syncthreads();
    if (map == 0) {
        const int r32e = opaque_v(r32);
        float sub[4];
#pragma unroll
        for (int d = 0; d < 4; ++d) sub[d] = subln[d * 32 + r32e] * oml;
#pragma unroll
        for (int r = 0; r < 16; ++r) {
            float ss = 0.f;
#pragma unroll
            for (int d = 0; d < 4; ++d) { const float v = o[d][r] * invr[r] - X[(d * 16 + r) * 64 + lane]; o[d][r] = v; ss += v * v; }
            ss = sum_row32(ss);
            const float rstd = __builtin_amdgcn_rsqf(ss * (1.f / 128.f) + EPS);
            gbf* yp = Y + (size_t)(tok0 + q0 + crow(r, hi)) * DM + h * 128 + r32e;
#pragma unroll
            for (int d = 0; d < 4; ++d) yp[d * 32] = (bf16_t)(cvt_pk_bf16(o[d][r] * rstd * sub[d], 0.f) & 0xffffu);
        }
    }
    __syncthreads();
}

__device__ __forceinline__ void unitB(LAS char* lds, const gbf* PROJ, const gbf* VT, gbf* Y, const int S, const int tok0, const int kvh, const int qblk, const gfl* sink, const int tid) {
    const int lane = tid & 63, r32 = lane & 31, hi = lane >> 5, wid = __builtin_amdgcn_readfirstlane(tid >> 6), gh = wid >> 1, sub = wid & 1;
    const int hq = kvh * 4 + gh;
    const int q0 = qblk * 64 + sub * 32;
    const float nslope = -LOG2E * __builtin_amdgcn_exp2f(-(float)(hq + 1));
    LAS float* wsf = (LAS float*)(lds + 131072) + wid * 64;
    const int NT = S >> 6;
    const int tlo = qblk - 2 < 0 ? 0 : qblk - 2, thi = qblk + 2 > NT - 1 ? NT - 1 : qblk + 2;
    const int srow = tid >> 3, sch = tid & 7;
    const gbf* ksrc = PROJ + (size_t)(tok0 + srow) * NPROJ + C_KB + kvh * 64 + sch * 8;
    const gbf* vsrc = VT + (size_t)(512 + kvh * 64 + srow) * MG + tok0 + sch * 8;
    const int kdst = srow * B_KP + sch * 16, vdst = B_KBYTES + srow * B_VP + sch * 16;
    bf16x8 qf[4];
    { const gbf* qp = PROJ + (size_t)(tok0 + q0 + r32) * NPROJ + C_QB + hq * 64 + hi * 8;
#pragma unroll
      for (int dc = 0; dc < 4; ++dc) qf[dc] = *(const GAS bf16x8*)(qp + dc * 16); }
    f32x16 o[2];
#pragma unroll
    for (int d = 0; d < 2; ++d)
#pragma unroll
        for (int r = 0; r < 16; ++r) o[d][r] = 0.f;
    float mref = sink[hq] * LOG2E, lsum = hi == 0 ? 1.f : 0.f;
    u32x4 kreg[5], vreg[5];
#pragma unroll
    for (int i = 0; i < 5; ++i) if (tlo + i <= thi) { kreg[i] = *(const GAS u32x4*)(ksrc + (size_t)((tlo + i) * 64) * NPROJ); vreg[i] = *(const GAS u32x4*)(vsrc + (tlo + i) * 64); }
#pragma unroll
    for (int i = 0; i < 5; ++i) if (tlo + i <= thi) { *(LAS u32x4*)(lds + i * B_BUF + kdst) = kreg[i]; *(LAS u32x4*)(lds + i * B_BUF + vdst) = vreg[i]; }
    __syncthreads();
    const int kpo = swap23(r32) * B_KP + hi * 16, vpo = B_KBYTES + r32 * B_VP + hi * 16;
    const float qposf = (float)(q0 + r32 - 8 * hi);
    for (int t = tlo; t <= thi; ++t) {
        const int bo = (t - tlo) * B_BUF;
        wave_tile<2, true, B_KP, B_VP>(lds + bo + kpo, lds + bo + vpo, qf, o, mref, lsum, (float)(t * 64) - qposf, nslope, wsf, r32, hi);
    }
    __syncthreads();
    const float inv = 1.f / sum_x32(lsum);
    if (hi == 0) wsf[r32] = inv;
#pragma unroll
    for (int r = 0; r < 16; ++r) { const float ir = wsf[crow(r, hi)];
        gbf* yp = Y + (size_t)(tok0 + q0 + crow(r, hi)) * DM + 512 + hq * 64 + r32;
#pragma unroll
        for (int d = 0; d < 2; ++d) yp[d * 32] = (bf16_t)(cvt_pk_bf16(o[d][r] * ir, 0.f) & 0xffffu); }
}
}

__device__ __forceinline__ void cvt_item(const gfl* W, int ldw, int k0, int n0, gbf* WT, int ldk, int drow0, float scale, LAS float* scr, int lane) {
#pragma unroll 8
    for (int i = 0; i < 32; ++i) { const int kk = 2 * i + (lane >> 5); scr[kk * 33 + (lane & 31)] = W[(size_t)(k0 + kk) * ldw + n0 + (lane & 31)]; }
    asm volatile("s_waitcnt lgkmcnt(0)" ::: "memory");
    const int c = lane & 7;
#pragma unroll
    for (int j = 0; j < 4; ++j) { const int n = (lane >> 3) + 8 * j; const LAS float* s = scr + (8 * c) * 33 + n;
        u32x4 o; o.x = cvt_pk_bf16(s[0 * 33] * scale, s[1 * 33] * scale); o.y = cvt_pk_bf16(s[2 * 33] * scale, s[3 * 33] * scale); o.z = cvt_pk_bf16(s[4 * 33] * scale, s[5 * 33] * scale); o.w = cvt_pk_bf16(s[6 * 33] * scale, s[7 * 33] * scale);
        *(GAS u32x4*)(WT + (size_t)(drow0 + n) * ldk + k0 + 8 * c) = o; }
    asm volatile("s_waitcnt lgkmcnt(0)" ::: "memory");
}
__device__ __forceinline__ bool cvt_seg(int& r, const gfl* W, int K, int ldw, int c0, int ncols, gbf* WT, int drow0, float scale, LAS float* scr, int lane, bool upperm = false) {
    const int nb = ncols / 32, cnt = (K / 64) * nb;
    if (r < cnt) { const int kb = r / nb, b = r % nb; int dr = drow0 + b * 32;
        if (upperm) { const int n = b * 32; dr = n < DFF ? 256 * (n / 128) + (n % 128) : 256 * ((n - DFF) / 128) + 128 + ((n - DFF) % 128); }
        cvt_item(W, ldw, kb * 64, c0 + b * 32, WT, K, dr, scale, scr, lane); return true; }
    r -= cnt; return false;
}

struct Params { const float* in[20]; float* out; unsigned char* ws; };
typedef const __attribute__((address_space(4))) Params* KP;

__device__ __forceinline__ void convert_weights(KP pk, LAS unsigned char* lds, int gw, int NGW, int wave, int lane) {
    LAS float* scr = (LAS float*)(lds + wave * 16384);
    constexpr int PER_LAYER = 16 * ((NPROJ + NVT) / 32) + 8 * 32 * 2 + 16 * 32 + 16 * (NUP / 32) + 44 * 32;
    for (int it = gw; it < 2 * PER_LAYER; it += NGW) {
        const int l = it / PER_LAYER; int r = it % PER_LAYER;
        gu8* wb = (gu8*)pk->ws + WS_W + (size_t)l * W_LAYER;
        gbf* W1T = (gbf*)(wb + W_W1T); gbf* WVT = (gbf*)(wb + W_WVT);
        const gfl* win = ((const gfl*)pk->in[3]) + (size_t)l * 1024 * 4352;
        if (cvt_seg(r, win, 1024, 4352, 0, 512, W1T, C_QA, QSCALE, scr, lane)) continue;
        if (cvt_seg(r, win, 1024, 4352, 512, 512, W1T, C_KA, 1.f, scr, lane)) continue;
        if (cvt_seg(r, win, 1024, 4352, 1024, 512, WVT, 0, 1.f, scr, lane)) continue;
        if (cvt_seg(r, win, 1024, 4352, 1536, 512, W1T, C_QB, QSCALE, scr, lane)) continue;
        if (cvt_seg(r, win, 1024, 4352, 2048, 128, W1T, C_KB, 1.f, scr, lane)) continue;
        if (cvt_seg(r, win, 1024, 4352, 2048, 128, W1T, C_KB + 128, 1.f, scr, lane)) continue;
        if (cvt_seg(r, win, 1024, 4352, 2176, 128, WVT, 512, 1.f, scr, lane)) continue;
        if (cvt_seg(r, win, 1024, 4352, 2176, 128, WVT, 640, 1.f, scr, lane)) continue;
        if (cvt_seg(r, win, 1024, 4352, 2304, 1024, W1T, C_GA, 1.f, scr, lane)) continue;
        if (cvt_seg(r, win, 1024, 4352, 3328, 1024, W1T, C_GB, 1.f, scr, lane)) continue;
        if (cvt_seg(r, ((const gfl*)pk->in[11]) + (size_t)l * 512 * 1024, 512, 1024, 0, 1024, (gbf*)(wb + W_WPA), 0, 1.f, scr, lane)) continue;
        if (cvt_seg(r, ((const gfl*)pk->in[12]) + (size_t)l * 512 * 1024, 512, 1024, 0, 1024, (gbf*)(wb + W_WPB), 0, 1.f, scr, lane)) continue;
        if (cvt_seg(r, ((const gfl*)pk->in[13]) + (size_t)l * 1024 * 1024, 1024, 1024, 0, 1024, (gbf*)(wb + W_WOUT), 0, 1.f, scr, lane)) continue;
        if (cvt_seg(r, ((const gfl*)pk->in[15]) + (size_t)l * 1024 * NUP, 1024, NUP, 0, NUP, (gbf*)(wb + W_WUP), 0, 1.f, scr, lane, true)) continue;
        cvt_seg(r, ((const gfl*)pk->in[18]) + (size_t)l * DFF * 1024, DFF, 1024, 0, 1024, (gbf*)(wb + W_WDOWN), 0, 1.f, scr, lane);
    }
}

__device__ __forceinline__ void rms_phase(const gfl* x, const gfl* g, gbf* out, int gw, int NGW, int lane) {
    f32x4 gv[4];
#pragma unroll
    for (int j = 0; j < 4; ++j) gv[j] = ((const GAS f32x4*)g)[lane + 64 * j];
    for (int m = gw; m < MG; m += NGW) {
        const GAS f32x4* xr = (const GAS f32x4*)(x + (size_t)m * DM) + lane;
        f32x4 v[4]; float s = 0.f;
#pragma unroll
        for (int j = 0; j < 4; ++j) { v[j] = xr[64 * j]; s += (v[j].x * v[j].x + v[j].y * v[j].y) + (v[j].z * v[j].z + v[j].w * v[j].w); }
        const float rstd = __builtin_amdgcn_rsqf(wave_sum(s) * (1.f / DM) + EPS);
        GAS unsigned long long* o8 = (GAS unsigned long long*)(out + (size_t)m * DM) + lane;
#pragma unroll
        for (int j = 0; j < 4; ++j) { const f32x4 w = v[j] * rstd * gv[j]; o8[64 * j] = (unsigned long long)cvt_pk_bf16(w.x, w.y) | ((unsigned long long)cvt_pk_bf16(w.z, w.w) << 32); }
    }
}
__device__ __forceinline__ void final_norm_phase(gfl* x, const gfl* g, int gw, int NGW, int lane) {
    f32x4 gv[4];
#pragma unroll
    for (int j = 0; j < 4; ++j) gv[j] = ((const GAS f32x4*)g)[lane + 64 * j];
    for (int m = gw; m < MG; m += NGW) {
        GAS f32x4* xr = (GAS f32x4*)(x + (size_t)m * DM) + lane;
        f32x4 v[4]; float s = 0.f;
#pragma unroll
        for (int j = 0; j < 4; ++j) { v[j] = xr[64 * j]; s += (v[j].x * v[j].x + v[j].y * v[j].y) + (v[j].z * v[j].z + v[j].w * v[j].w); }
        const float rstd = __builtin_amdgcn_rsqf(wave_sum(s) * (1.f / DM) + EPS);
#pragma unroll
        for (int j = 0; j < 4; ++j) xr[64 * j] = v[j] * rstd * gv[j];
    }
}

__device__ __forceinline__ void unpack8(const u32x4 w, float (&f)[8]) { f[0] = bf_lo(w.x); f[1] = bf_hi(w.x); f[2] = bf_lo(w.y); f[3] = bf_hi(w.y); f[4] = bf_lo(w.z); f[5] = bf_hi(w.z); f[6] = bf_lo(w.w); f[7] = bf_hi(w.w); }
__device__ __forceinline__ void conv_phase(gbf* UP, const gfl* cw, const gfl* cb, int S, int gtid, int NT) {
    constexpr int NCC = DFF / 8, RUN = 32, NTASK = (MG / RUN) * NCC;
    for (int task = gtid; task < NTASK; task += NT) {
        const int cc = task % NCC, rr = task / NCC, f0 = cc * 8, row0 = rr * RUN, p0 = row0 & (S - 1);
        float w0[8], w1[8], w2[8], bb[8];
#pragma unroll
        for (int i = 0; i < 8; ++i) { w0[i] = cw[f0 + i]; w1[i] = cw[DFF + f0 + i]; w2[i] = cw[2 * DFF + f0 + i]; bb[i] = cb[f0 + i]; }
        const gbf* ap = UP + (size_t)row0 * NUP + f0;
        gbf* vp = UP + (size_t)row0 * NUP + DFF + f0;
        float prev[8], cur[8], nxt[8];
        if (p0 == 0) {
#pragma unroll
            for (int i = 0; i < 8; ++i) prev[i] = 0.f;
        } else unpack8(*(const GAS u32x4*)(ap - NUP), prev);
        unpack8(*(const GAS u32x4*)ap, cur);
        for (int r = 0; r < RUN; ++r) {
            if (p0 + r + 1 == S) {
#pragma unroll
                for (int i = 0; i < 8; ++i) nxt[i] = 0.f;
            } else unpack8(*(const GAS u32x4*)(ap + (size_t)(r + 1) * NUP), nxt);
            float vv[8]; unpack8(*(const GAS u32x4*)(vp + (size_t)r * NUP), vv);
            float gsv[8];
#pragma unroll
            for (int i = 0; i < 8; ++i) {
                const float c = prev[i] * w0[i] + cur[i] * w1[i] + nxt[i] * w2[i] + bb[i];
                const float u = 0.7978845608028654f * (c + 0.044715f * c * c * c);
                const float ge = c * __builtin_amdgcn_rcpf(1.f + __builtin_amdgcn_exp2f(-2.f * LOG2E * u));
                gsv[i] = ge * vv[i]; prev[i] = cur[i]; cur[i] = nxt[i];
            }
            u32x4 w; w.x = cvt_pk_bf16(gsv[0], gsv[1]); w.y = cvt_pk_bf16(gsv[2], gsv[3]); w.z = cvt_pk_bf16(gsv[4], gsv[5]); w.w = cvt_pk_bf16(gsv[6], gsv[7]);
            *(GAS u32x4*)(vp + (size_t)r * NUP) = w;
        }
    }
}

#define XB_TMO      128
#define XB_XCNT(j)  (256  + 64 * (j))
#define XB_XSUB(j)  (1280 + 64 * (j))
#define XB_XGEN(j)  (2304 + 64 * (j))
#define XB_TOP      3328
#define XB_TOPGEN   3392
#define XCD_BAR_WORDS 3456
#define XB_SPIN_CAP (1u << 22)
__device__ __forceinline__ unsigned xb_ld(unsigned* p)              { return __hip_atomic_load(p, __ATOMIC_RELAXED, __HIP_MEMORY_SCOPE_AGENT); }
__device__ __forceinline__ unsigned xb_add(unsigned* p, unsigned v) { return __hip_atomic_fetch_add(p, v, __ATOMIC_RELAXED, __HIP_MEMORY_SCOPE_AGENT); }
__device__ __forceinline__ unsigned xb_xcc_id() { return (unsigned)__builtin_amdgcn_s_getreg((3 << 11) | 20) & 0xFu; }
#define XB_SPIN(cond, bar) do { unsigned _sp = 0; while (cond) { __builtin_amdgcn_s_sleep(1); \
    if ((++_sp & 255u) == 0u) { if (xb_ld(&(bar)[XB_TMO])) break; if (_sp > XB_SPIN_CAP) { atomicAdd(&(bar)[XB_TMO], 1u); break; } } } } while (0)
struct XcdBarrier { unsigned* bar; unsigned x; volatile LAS unsigned* st; };
__device__ __forceinline__ void xcd_barrier_complete(unsigned* bar, unsigned x, unsigned& nloc, unsigned& nx) {
    const unsigned G = gridDim.x * gridDim.y * gridDim.z;
    unsigned sum, cnt, mine, sp = 0u;
    for (;;) {
        sum = 0u; cnt = 0u; mine = 0u;
#pragma unroll
        for (unsigned j = 0; j < 16; ++j) { const unsigned c = xb_ld(&bar[XB_XCNT(j)]); sum += c; cnt += (c > 0u) ? 1u : 0u; mine = (j == x) ? c : mine; }
        if (sum == G) break;
        __builtin_amdgcn_s_sleep(1);
        if ((++sp & 255u) == 0u) { if (xb_ld(&bar[XB_TMO])) break; if (sp > XB_SPIN_CAP) { atomicAdd(&bar[XB_TMO], 1u); break; } }
    }
    nloc = mine > 0u ? mine : 1u; nx = cnt > 0u ? cnt : 1u;
}
__device__ __forceinline__ void xcd_barrier(const XcdBarrier& b) {
    asm volatile("s_waitcnt vmcnt(0)" ::: "memory");
    __syncthreads();
    if (threadIdx.x == 0) {
        unsigned* bar = b.bar;
        __builtin_amdgcn_s_waitcnt(0);
        unsigned nloc = b.st[0], nx = b.st[1];
        if (nloc == 0u) { xcd_barrier_complete(bar, b.x, nloc, nx); b.st[0] = nloc; b.st[1] = nx; }
        const unsigned old = xb_add(&bar[XB_XSUB(b.x)], 1u);
        const unsigned gen = old / nloc;
        if (old + 1u == (gen + 1u) * nloc) {
            __builtin_amdgcn_fence(__ATOMIC_RELEASE, "agent");
            asm volatile("s_waitcnt vmcnt(0)" ::: "memory");
            const unsigned og = xb_add(&bar[XB_TOP], 1u);
            const unsigned tg = og / nx;
            if (og + 1u == (tg + 1u) * nx) xb_add(&bar[XB_TOPGEN], 1u);
            else XB_SPIN(xb_ld(&bar[XB_TOPGEN]) == tg, bar);
            __builtin_amdgcn_fence(__ATOMIC_ACQUIRE, "agent");
            xb_add(&bar[XB_XGEN(b.x)], 1u);
            asm volatile("s_waitcnt vmcnt(0)" ::: "memory");
        } else {
            XB_SPIN(xb_ld(&bar[XB_XGEN(b.x)]) == gen, bar);
            __builtin_amdgcn_fence(__ATOMIC_ACQUIRE, "agent");
            asm volatile("s_waitcnt vmcnt(0)" ::: "memory");
        }
    }
    __syncthreads();
}

constexpr int LDS_BYTES = 131072 + 4096 + 64;
constexpr int BARST_OFF = 131072 + 4096;
constexpr size_t WS_BAR = 31 * MiB + 768 * 1024;
static_assert(att::ATT_LDS2 <= LDS_BYTES, "attention LDS");
__device__ __forceinline__ KP kargs() { KP q = (KP)__builtin_amdgcn_kernarg_segment_ptr(); asm volatile("" : "+s"(q)); return q; }
__device__ __forceinline__ int opaque(int v) { asm volatile("" : "+s"(v)); return v; }
#define PHASE_COMMON \
    KP pp = kargs(); const int l = opaque(l_), g = opaque(g_); \
    const int wave = opaque(wave0_); const int lane = (int)__builtin_amdgcn_mbcnt_hi(~0u, __builtin_amdgcn_mbcnt_lo(~0u, (unsigned)opaque_v(0))); const int tid = wave * 64 + lane; \
    const int G = opaque((int)gridDim.x), bx = blockIdx.x; const int vcu = (G % 8 == 0) ? (bx % 8) * (G / 8) + bx / 8 : bx; const int gw = vcu * 8 + wave, NGW = G * 8; \
    gu8* ws = (gu8*)pp->ws; gu8* wb = ws + WS_W + (size_t)l * W_LAYER; \
    gbf* HB = (gbf*)(ws + WS_HB); gbf* PROJ = (gbf*)(ws + WS_PROJ); gbf* VT = (gbf*)(ws + WS_VT); gbf* Y = (gbf*)(ws + WS_Y); gbf* GB = (gbf*)(ws + WS_G); gu64* SSA = (gu64*)(ws + WS_SSA); gu64* SSB = (gu64*)(ws + WS_SSB); \
    const gfl* xin = (const gfl*)pp->in[g]; gfl* xo = (gfl*)pp->out + (size_t)g * MG * DM; const int S = g ? 8192 : 4096, NB = MG / S; \
    (void)lane; (void)wave; (void)vcu; (void)gw; (void)NGW; (void)wb; (void)HB; (void)PROJ; (void)VT; (void)Y; (void)GB; (void)SSA; (void)SSB; (void)xin; (void)xo; (void)S; (void)NB; (void)tid;

__global__ void __launch_bounds__(512, 2) mega_fwd(Params p) {
    extern __shared__ __attribute__((aligned(16))) unsigned char lds_raw[];
    LAS unsigned char* lds = (LAS unsigned char*)lds_raw;
    cg::grid_group grid = cg::this_grid();
    const int wave0_ = __builtin_amdgcn_readfirstlane((int)threadIdx.x >> 6);
    if (threadIdx.x < 2) ((LAS unsigned*)(lds + BARST_OFF))[threadIdx.x] = 0u;
    __syncthreads();
    if (threadIdx.x == 0) (void)xb_add((unsigned*)(kargs()->ws + WS_BAR) + XB_XCNT(xb_xcc_id()), 1u);
    grid.sync();
#define GBAR() do { XcdBarrier b_; b_.bar = (unsigned*)(kargs()->ws + WS_BAR); b_.x = xb_xcc_id(); b_.st = (volatile LAS unsigned*)(lds + BARST_OFF); xcd_barrier(b_); } while (0)
    { const int l_ = 0, g_ = 0; PHASE_COMMON
      if (bx == 0 && tid < 256) ((GAS unsigned*)(ws + WS_KN2))[tid] = 0u;
      if (bx == 0 && tid < 64) ((GAS unsigned*)(ws + WS_Q))[tid * 16] = 0u;
      convert_weights(pp, lds, gw, NGW, wave, lane); }

    for (int g_ = 0; g_ < 2; ++g_) {
        for (int l_ = 0; l_ < 2; ++l_) {
            if (l_ == 0) {
                { PHASE_COMMON
                  rms_phase(xin, ((const gfl*)pp->in[2]), HB, gw, NGW, lane); }
                GBAR();
            }
            { PHASE_COMMON
              pg8::Gemm gm{HB, (const gbf*)(wb + W_W1T), MG, NPROJ, DM, DM, DM}; pg8::StaticOrder so; so.init(MG, NPROJ, G, bx); pg8::EpiStoreRow E{PROJ, (size_t)NPROJ, l ? SSB : nullptr, (GAS unsigned*)(ws + WS_KN2), S};
              pg8::gemm_phase<pg8::EpiStoreRow, pg8::StaticOrder, true>(lds, gm, so, E, tid); }
            { PHASE_COMMON
              pg8::Gemm gm{(const gbf*)(wb + W_WVT), HB, NVT, MG, DM, DM, DM}; pg8::StaticOrder so; so.init(NVT, MG, G, bx); pg8::EpiStoreCol E{VT, (size_t)MG, l ? SSB : nullptr};
              pg8::gemm_phase<pg8::EpiStoreCol, pg8::StaticOrder, true>(lds, gm, so, E, tid); }
            GBAR();
            { PHASE_COMMON
              { gu64* z = (gu64*)(ws + WS_SSA); for (int i = bx * 512 + tid; i < 2 * MG; i += G * 512) z[i] = 0ull; }
              const float lam_init = l == 0 ? 0.2f : 0.35550906758f;
              float d1 = 0.f, d2 = 0.f;
              for (int i = 0; i < 64; ++i) { d1 += ((const gfl*)pp->in[5])[l * 64 + i] * ((const gfl*)pp->in[6])[l * 64 + i]; d2 += ((const gfl*)pp->in[7])[l * 64 + i] * ((const gfl*)pp->in[8])[l * 64 + i]; }
              const float lam = unif(__expf(d1) - __expf(d2) + lam_init);
              const int NQA = S / 128, nA = NB * 4 * NQA;
              const gfl* subln = uni(((const gfl*)pp->in[9]) + l * 128);
              const GAS unsigned* kn2 = uni((const GAS unsigned*)(ws + WS_KN2));
              const float oml = unif(1.f - lam_init);
              if (G == 256) {
                  LAS unsigned* qs = (LAS unsigned*)(lds + BARST_OFF + 16);
                  const unsigned xme = xb_xcc_id() & 7u;
                  for (unsigned sx = 0; sx < 8; ++sx) {
                      const unsigned x = (xme + sx) & 7u;
                      GAS unsigned* qh = (GAS unsigned*)(ws + WS_Q) + ((g * 2 + l) * 16 + (int)x) * 16;
                      for (;;) {
                          if (tid == 0) *qs = __hip_atomic_fetch_add(qh, 1u, __ATOMIC_RELAXED, __HIP_MEMORY_SCOPE_AGENT);
                          __syncthreads();
                          const unsigned j = (unsigned)__builtin_amdgcn_readfirstlane((int)*qs);
                          __syncthreads();
                          if (j >= 256u) break;
                          const int r = (int)(j >> 5), i = ((3 - (r >> 1)) & 3) + 4 * (r & 1), c = ((int)(j & 31u) + 4 * i) & 31, top = i >> 2, h = i & 3;
                          int b, qblk;
                          if (NQA == 32) { b = 2 * (int)x + top; qblk = c; } else { b = (int)x; qblk = c + 32 * top; }
                          const float kn2a = __uint_as_float(kn2[b * 16 + h * 4 + 0]) + __uint_as_float(kn2[b * 16 + h * 4 + 1]), kn2b = __uint_as_float(kn2[b * 16 + h * 4 + 2]) + __uint_as_float(kn2[b * 16 + h * 4 + 3]);
                          att::unitA((LAS char*)lds, uni(PROJ), uni(VT), uni(Y), S, b * S, h, qblk, lam, oml, subln, unif(kn2a), unif(kn2b), tid);
                      }
                  }
              } else
              for (int u = vcu; u < nA; u += G) {
                  const int qblk = u & (NQA - 1), bh = u >> (NQA == 32 ? 5 : 6), h = bh & 3, b = bh >> 2;
                  const float kn2a = __uint_as_float(kn2[b * 16 + h * 4 + 0]) + __uint_as_float(kn2[b * 16 + h * 4 + 1]), kn2b = __uint_as_float(kn2[b * 16 + h * 4 + 2]) + __uint_as_float(kn2[b * 16 + h * 4 + 3]);
                  att::unitA((LAS char*)lds, uni(PROJ), uni(VT), uni(Y), S, b * S, h, qblk, lam, oml, subln, unif(kn2a), unif(kn2b), tid); } }
            { PHASE_COMMON
              const int NQB = S / 64, nB = NB * 2 * NQB;
              const gfl* sink = ((const gfl*)pp->in[10]) + l * 8;
              for (int u = vcu; u < nB; u += G) { const int qblk = u % NQB, bk = u / NQB, kvh = bk & 1, b = bk >> 1;
                  att::unitB((LAS char*)lds, PROJ, VT, Y, S, b * S, kvh, qblk, sink, tid); } }
            GBAR();
            { PHASE_COMMON
              pg8::Gemm gm{Y, (const gbf*)(wb + W_WPA), MG, DM, 512, DM, 512}; pg8::StaticOrder so; so.init(MG, DM, G, bx); pg8::EpiGate<false> E{HB, DM, PROJ + C_GA, NPROJ, ((const gfl*)pp->in[4]) + l * 2048};
              pg8::gemm_phase<pg8::EpiGate<false>, pg8::StaticOrder, true>(lds, gm, so, E, tid); }
            { PHASE_COMMON
              pg8::Gemm gm{Y + 512, (const gbf*)(wb + W_WPB), MG, DM, 512, DM, 512}; pg8::StaticOrder so; so.init(MG, DM, G, bx); pg8::EpiGate<true> E{HB, DM, PROJ + C_GB, NPROJ, ((const gfl*)pp->in[4]) + l * 2048 + 1024};
              pg8::gemm_phase<pg8::EpiGate<true>, pg8::StaticOrder, true>(lds, gm, so, E, tid); }
            GBAR();
            { PHASE_COMMON
              pg8::Gemm gm{HB, (const gbf*)(wb + W_WOUT), MG, DM, DM, DM, DM}; pg8::StaticOrder so; so.init(MG, DM, G, bx);
              if (bx == 0 && tid < 256) ((GAS unsigned*)(ws + WS_KN2))[tid] = 0u;
              pg8::EpiResidNorm E{l == 0 ? xin : xo, xo, DM, Y, ((const gfl*)pp->in[14]) + l * DM, SSA, true};
              pg8::gemm_phase<pg8::EpiResidNorm, pg8::StaticOrder, true>(lds, gm, so, E, tid); }
            GBAR();
            { PHASE_COMMON
              pg8::Gemm gm{uni(Y), uni((const gbf*)(wb + W_WUP)), MG, NUP, DM, DM, DM}; pg8::StaticOrder so; so.init_tiles((MG + 253) / 254, NUP / 256, G, bx);
              pg8::EpiConv E{uni(GB), uni(SSA), uni(((const gfl*)pp->in[16]) + (size_t)l * 3 * DFF), uni(((const gfl*)pp->in[17]) + (size_t)l * DFF), (LAS float*)(lds + 131072), S, MG};
              pg8::gemm_phase<pg8::EpiConv, pg8::StaticOrder, true, 254>(lds, gm, so, E, tid); }
            GBAR();
            { PHASE_COMMON
              pg8::Gemm gm{GB, (const gbf*)(wb + W_WDOWN), MG, DM, DFF, DFF, DFF}; pg8::StaticOrder so; so.init(MG, DM, G, bx);
              pg8::EpiResidNorm E{xo, xo, DM, HB, ((const gfl*)pp->in[2]) + DM, SSB, l == 0};
              pg8::gemm_phase<pg8::EpiResidNorm, pg8::StaticOrder, true>(lds, gm, so, E, tid); }
            GBAR();
        }
        { const int l_ = 0; PHASE_COMMON
          final_norm_phase(xo, ((const gfl*)pp->in[19]), gw, NGW, lane); }
    }
}

extern "C" void kernel_launch(void* const* d_in, const int* in_sizes, int n_in, void* d_out, int out_size, void* d_ws, size_t ws_size, hipStream_t stream) {
    static int grid = 0;
    if (grid == 0) {
        if (n_in != 20 || ws_size < WS_END) { fprintf(stderr, "kernel_launch: need 20 inputs and >= %zu bytes of workspace (got %d, %zu)\n", (size_t)WS_END, n_in, ws_size); grid = -1; return; }
        int dev = 0, cus = 0, per_cu = 0;
        hipGetDevice(&dev); hipDeviceGetAttribute(&cus, hipDeviceAttributeMultiprocessorCount, dev);
        if (hipFuncSetAttribute((const void*)mega_fwd, hipFuncAttributeMaxDynamicSharedMemorySize, LDS_BYTES) != hipSuccess) { fprintf(stderr, "kernel_launch: hipFuncSetAttribute failed\n"); grid = -1; return; }
        hipOccupancyMaxActiveBlocksPerMultiprocessor(&per_cu, (const void*)mega_fwd, 512, LDS_BYTES);
        (void)hipGetLastError();
        if (per_cu < 1) fprintf(stderr, "kernel_launch: occupancy query says %d blocks per CU\n", per_cu);
        grid = cus;
    }
    if (grid < 0) return;
    if (hipMemsetAsync((char*)d_ws + WS_BAR, 0, 16384, stream) != hipSuccess) { fprintf(stderr, "kernel_launch: hipMemsetAsync failed\n"); return; }
    Params p{};
    for (int i = 0; i < 20; ++i) p.in[i] = (const float*)d_in[i];
    p.out = (float*)d_out; p.ws = (unsigned char*)d_ws;
    void* args[] = {&p};
    hipError_t e = hipLaunchCooperativeKernel((const void*)mega_fwd, dim3(grid), dim3(512), args, LDS_BYTES, stream);
    if (e != hipSuccess) fprintf(stderr, "cooperative launch failed: %s (grid %d)\n", hipGetErrorString(e), grid);
}
```
